# Optimizing an MI355X kernel written in HIP

```python
import math
import jax, jax.numpy as jnp
from jax import lax
import numpy as np

D_MODEL = 1024
BATCH = 4
SEQ = 4096
DEPTH = 1

GRID_W = 64
NA_WIDTH = D_MODEL // 2
NA_HEAD_DIM = 64
NA_HEADS = NA_WIDTH // NA_HEAD_DIM
NA_KH_MAX = 8
NA_KW = 16
S5_WIDTH = D_MODEL // 2
S5_GROUP = 16
S5_GROUPS = S5_WIDTH // S5_GROUP
S5_STATE = 64
DT_MIN = 1e-3
DT_MAX = 1e-1
MEM_TOKENS = 256
MEM_HEADS = 4
MEM_WIDTH = D_MODEL // 2
MEM_HEAD_DIM = MEM_WIDTH // MEM_HEADS
N_BRANCH = 3
BRANCH_WIDTH = D_MODEL // 2
IN_WIDTH = 3 * NA_WIDTH + S5_WIDTH + MEM_WIDTH
D_FF = -(-8 * D_MODEL // (3 * 256)) * 256
EPS = 1e-6
NEG_INF = -1e30

kernel_name = "hybrid_natten_s5_memxattn_gated_block"


def rms_norm(x, g):
    x32 = x.astype(jnp.float32)
    y = x32 * lax.rsqrt(jnp.mean(x32 * x32, axis=-1, keepdims=True) + EPS)
    return (y * g.astype(jnp.float32)).astype(x.dtype)


def neighbourhood_attention(q, k, v, rpb):
    b, s, h, dh = q.shape
    rows = s // GRID_W
    kh = min(NA_KH_MAX, rows)
    qg = q.reshape(b, rows, GRID_W, h, dh)
    kg = k.reshape(b, rows, GRID_W, h, dh)
    vg = v.reshape(b, rows, GRID_W, h, dh)
    r = jnp.arange(rows)
    row_start = jnp.clip(r - kh // 2, 0, rows - kh)
    row_idx = row_start[:, None] + jnp.arange(kh)[None, :]
    k_band = kg[:, row_idx]
    v_band = vg[:, row_idx]
    scores = jnp.einsum('brqhd,brikhd->bhrqik', qg, k_band).astype(jnp.float32) * (dh ** -0.5)
    c = jnp.arange(GRID_W)
    col_start = jnp.clip(c - NA_KW // 2, 0, GRID_W - NA_KW)
    in_win = (c[None, :] >= col_start[:, None]) & (c[None, :] < col_start[:, None] + NA_KW)
    rel_row = row_idx - r[:, None] + (NA_KH_MAX - 1)
    rel_col = jnp.clip(c[None, :] - c[:, None] + (NA_KW - 1), 0, 2 * NA_KW - 2)
    bias = rpb[:, rel_row[:, None, :, None], rel_col[None, :, None, :]]
    scores = jnp.where(in_win[:, None, :], scores + bias[None].astype(jnp.float32), NEG_INF)
    probs = jax.nn.softmax(scores.reshape(b, h, rows, GRID_W, kh * GRID_W), axis=-1)
    probs = probs.reshape(b, h, rows, GRID_W, kh, GRID_W).astype(v.dtype)
    out = jnp.einsum('bhrqik,brikhd->brqhd', probs, v_band)
    return out.reshape(b, s, h * dh)


def _ssm_combine(e1, e2):
    a1, b1 = e1
    a2, b2 = e2
    return a2 * a1, a2 * b1 + b2


def s5_bidirectional(u, a_re, a_im, log_dt, b_re, b_im, c_re, c_im, d, w_glu):
    bsz, s, _ = u.shape
    f32 = jnp.float32
    u32 = u.astype(f32)
    ug = u32.reshape(bsz, s, S5_GROUPS, S5_GROUP).astype(jnp.complex64)
    y = d.astype(f32) * u32
    for direction, reverse in ((0, False), (1, True)):
        lam = lax.complex(a_re[direction].astype(f32), a_im[direction].astype(f32))
        dt = jnp.exp(log_dt[direction].astype(f32))[:, None]
        lam_bar = jnp.exp(lam * dt)
        b = lax.complex(b_re[direction].astype(f32), b_im[direction].astype(f32))
        b_bar = ((lam_bar - 1.0) / lam)[..., None] * b
        bu = jnp.einsum('bsgc,gpc->bsgp', ug, b_bar)
        a = jnp.broadcast_to(lam_bar, bu.shape)
        _, states = lax.associative_scan(_ssm_combine, (a, bu), reverse=reverse, axis=1)
        cm = lax.complex(c_re[direction].astype(f32), c_im[direction].astype(f32))
        y = y + jnp.einsum('bsgp,gcp->bsgc', states, cm).real.reshape(bsz, s, S5_WIDTH)
    z = jax.nn.gelu(y)
    out = z * jax.nn.sigmoid(z @ w_glu.astype(f32))
    return out.astype(u.dtype)


def memory_cross_attention(q, mem_n, w_mem_kv):
    b, s, _ = q.shape
    m = mem_n.shape[1]
    kv = mem_n @ w_mem_kv
    k, v = jnp.split(kv, 2, axis=-1)
    qh = q.reshape(b, s, MEM_HEADS, MEM_HEAD_DIM)
    kh = k.reshape(b, m, MEM_HEADS, MEM_HEAD_DIM)
    vh = v.reshape(b, m, MEM_HEADS, MEM_HEAD_DIM)
    scores = jnp.einsum('bshd,bmhd->bhsm', qh, kh).astype(jnp.float32) * (MEM_HEAD_DIM ** -0.5)
    probs = jax.nn.softmax(scores, axis=-1).astype(vh.dtype)
    return jnp.einsum('bhsm,bmhd->bshd', probs, vh).reshape(b, s, MEM_WIDTH)


def setup_inputs(seed: int = 0) -> dict:
    key = jax.random.key(seed)
    ks = jax.random.split(key, 32)
    f32 = jnp.float32
    L = DEPTH

    def nrm(i, shape, scale):
        return jax.random.normal(ks[i], shape, f32) * scale

    n = jnp.arange(S5_STATE, dtype=f32)
    log_dt = math.log(DT_MIN) + jax.random.uniform(ks[13], (L, 2, S5_GROUPS), f32) * (math.log(DT_MAX) - math.log(DT_MIN))
    return {
        "x": nrm(0, (BATCH, SEQ, D_MODEL), 1.0),
        "mem": nrm(1, (BATCH, MEM_TOKENS, D_MODEL), 1.0),
        "g_mix": 1.0 + nrm(2, (L, D_MODEL), 0.02),
        "g_mem": 1.0 + nrm(3, (L, D_MODEL), 0.02),
        "g_ffn": 1.0 + nrm(4, (L, D_MODEL), 0.02),
        "g_final": 1.0 + nrm(5, (D_MODEL,), 0.02),
        "w_in": nrm(6, (L, D_MODEL, IN_WIDTH), D_MODEL ** -0.5),
        "w_gate": nrm(7, (L, D_MODEL, N_BRANCH * D_MODEL), D_MODEL ** -0.5),
        "b_gate": nrm(8, (L, N_BRANCH * D_MODEL), 0.01),
        "rpb": nrm(9, (L, NA_HEADS, 2 * NA_KH_MAX - 1, 2 * NA_KW - 1), 0.02),
        "w_mem_kv": nrm(10, (L, D_MODEL, 2 * MEM_WIDTH), D_MODEL ** -0.5),
        "a_re": -0.5 + nrm(11, (L, 2, S5_GROUPS, S5_STATE), 0.01),
        "a_im": math.pi * n + nrm(12, (L, 2, S5_GROUPS, S5_STATE), 0.01),
        "log_dt": log_dt,
        "b_re": nrm(14, (L, 2, S5_GROUPS, S5_STATE, S5_GROUP), (2 * S5_GROUP) ** -0.5),
        "b_im": nrm(15, (L, 2, S5_GROUPS, S5_STATE, S5_GROUP), (2 * S5_GROUP) ** -0.5),
        "c_re": nrm(16, (L, 2, S5_GROUPS, S5_GROUP, S5_STATE), S5_STATE ** -0.5),
        "c_im": nrm(17, (L, 2, S5_GROUPS, S5_GROUP, S5_STATE), S5_STATE ** -0.5),
        "s5_d": nrm(18, (L, S5_WIDTH), 1.0),
        "w_glu": nrm(19, (L, S5_WIDTH, S5_WIDTH), S5_WIDTH ** -0.5),
        "w_branch": nrm(20, (L, N_BRANCH, BRANCH_WIDTH, D_MODEL), BRANCH_WIDTH ** -0.5),
        "w_o": nrm(21, (L, D_MODEL, D_MODEL), D_MODEL ** -0.5),
        "w_ffn1": nrm(22, (L, D_MODEL, D_FF), D_MODEL ** -0.5),
        "w_ffn3": nrm(23, (L, D_MODEL, D_FF), D_MODEL ** -0.5),
        "w_ffn2": nrm(24, (L, D_FF, D_MODEL), D_FF ** -0.5),
    }


def reference(x, mem, g_mix, g_mem, g_ffn, g_final, w_in, w_gate, b_gate, rpb, w_mem_kv,
              a_re, a_im, log_dt, b_re, b_im, c_re, c_im, s5_d, w_glu, w_branch, w_o,
              w_ffn1, w_ffn3, w_ffn2):
    bsz, s, d = x.shape
    split_at = [NA_WIDTH, 2 * NA_WIDTH, 3 * NA_WIDTH, 3 * NA_WIDTH + S5_WIDTH]
    for l in range(DEPTH):
        h = rms_norm(x, g_mix[l])
        proj = h @ w_in[l]
        q_na, k_na, v_na, u_s5, q_mem = jnp.split(proj, split_at, axis=-1)
        hd = (bsz, s, NA_HEADS, NA_HEAD_DIM)
        y_na = neighbourhood_attention(q_na.reshape(hd), k_na.reshape(hd), v_na.reshape(hd), rpb[l])
        y_s5 = s5_bidirectional(u_s5, a_re[l], a_im[l], log_dt[l], b_re[l], b_im[l],
                                c_re[l], c_im[l], s5_d[l], w_glu[l])
        y_mem = memory_cross_attention(q_mem, rms_norm(mem, g_mem[l]), w_mem_kv[l])
        ys = jnp.stack([y_na, y_s5, y_mem], axis=2)
        up = jnp.einsum('bsnc,ncd->bsnd', ys, w_branch[l])
        gates = jax.nn.sigmoid(h @ w_gate[l] + b_gate[l]).reshape(bsz, s, N_BRANCH, d)
        merged = jnp.sum(gates * up, axis=2)
        x = x + merged @ w_o[l]
        h2 = rms_norm(x, g_ffn[l])
        x = x + (jax.nn.silu(h2 @ w_ffn1[l]) * (h2 @ w_ffn3[l])) @ w_ffn2[l]
    return rms_norm(x, g_final)
```

```cpp
#include <hip/hip_runtime.h>
#include <cstdio>
#include <cstdint>

#define LAS __attribute__((address_space(3)))
#define GAS __attribute__((address_space(1)))
typedef unsigned short bf16;
typedef short bf16x8 __attribute__((ext_vector_type(8)));
typedef float f32x4 __attribute__((ext_vector_type(4)));
typedef float f32x2 __attribute__((ext_vector_type(2)));
typedef unsigned u32x4 __attribute__((ext_vector_type(4)));
typedef unsigned u32x2 __attribute__((ext_vector_type(2)));

constexpr int NB = 4, SEQ = 4096, T = NB * SEQ, D = 1024;
constexpr int NIN = 2560, DFF = 2816;
constexpr int CL = 32, NCH = SEQ / CL, NCR = NB * NCH, U2K = 768;
constexpr float EPS = 1e-6f;

constexpr size_t MiB = 1u << 20;
constexpr size_t WS_CTL = 0, CTL_ZERO_BYTES = 1 * MiB;
constexpr size_t WS_SS1 = 256 * 1024, WS_SS2 = 384 * 1024;
constexpr size_t WS_WIN = 2 * MiB, WS_WG = 7 * MiB, WS_WUP = 13 * MiB, WS_WO = 16 * MiB, WS_WGLU = 18 * MiB, WS_WMKV = 19 * MiB, WS_W13 = 21 * MiB, WS_W2 = 32 * MiB;
constexpr size_t WS_MEMN = 38 * MiB, WS_KVM = 40 * MiB, WS_WEND = 42 * MiB, WS_WTOEP = 50 * MiB, WS_KT = 74 * MiB;
constexpr size_t WS_MERGED = 42 * MiB;
constexpr size_t WS_H = 76 * MiB, WS_Q = 108 * MiB, WS_K = 124 * MiB, WS_V = 140 * MiB, WS_QM = 156 * MiB, WS_U2 = 172 * MiB, WS_SLOC = 196 * MiB, WS_Z = 212 * MiB, WS_YS5 = 228 * MiB;
constexpr size_t WS_G = 172 * MiB;
constexpr size_t WS_X1B = 108 * MiB;
constexpr size_t WS_TT = 140 * MiB;
constexpr size_t WS_END = 256 * MiB;
constexpr int CW_BAR = 4096;

__device__ __forceinline__ unsigned f2bf(float f) { unsigned u = __float_as_uint(f); return (u + 0x7fffu + ((u >> 16) & 1u)) >> 16; }
__device__ __forceinline__ unsigned pk2(float lo, float hi) { return f2bf(lo) | (f2bf(hi) << 16); }
__device__ __forceinline__ float bf2f(unsigned h) { return __uint_as_float(h << 16); }
__device__ __forceinline__ float bflo(unsigned w) { return __uint_as_float(w << 16); }
__device__ __forceinline__ float bfhi(unsigned w) { return __uint_as_float(w & 0xffff0000u); }
__device__ __forceinline__ unsigned cvt_pk_bf16(float lo, float hi) { unsigned r; asm volatile("v_cvt_pk_bf16_f32 %0, %1, %2" : "=v"(r) : "v"(lo), "v"(hi)); return r; }
__device__ __forceinline__ float sigmoidf_(float x) { return __builtin_amdgcn_rcpf(1.0f + __expf(-x)); }
__device__ __forceinline__ float gelu_tanh(float x) { const float a = 1.5957691216057308f * (x + 0.044715f * x * x * x); return x * sigmoidf_(a); }
__device__ __forceinline__ float wave_sum(float v) {
#pragma unroll
    for (int o = 1; o < 64; o <<= 1) v += __shfl_xor(v, o);
    return v;
}
__device__ __forceinline__ float wave_max(float v) {
#pragma unroll
    for (int o = 1; o < 64; o <<= 1) v = fmaxf(v, __shfl_xor(v, o));
    return v;
}

namespace pg8 {
constexpr int BM = 256, BK = 64, HALF = 128, HTB = HALF * BK * 2, STAGE_BYTES = 8 * HTB;
__host__ __device__ __forceinline__ int lds_byte(int r, int c) { const int st = (r >> 4) * 2 + (c >> 5), rr = r & 15, cc = c & 31, ob = rr * 64 + cc * 2; return st * 1024 + (ob ^ (((ob >> 9) & 1) << 5)); }
__host__ __device__ __forceinline__ void stage_rc(int b, int& R, int& C) { const int st = b / 1024, sb = b % 1024, swz = sb ^ (((sb >> 9) & 1) << 5); R = (st >> 1) * 16 + swz / 64; C = (st & 1) * 32 + (swz % 64) / 2; }
__host__ __device__ __forceinline__ int perm32(int rho) { const int n = rho >> 4, i = rho & 15; return 8 * (i >> 2) + 4 * n + (i & 3); }

struct Unit { const char* A; const char* B; unsigned lda, ldb; int nt, kind, pm, pn; };

__device__ __forceinline__ void tile_order(int wgid, int nM, int nN, int& pm, int& pn) {
    const int nwg = nM * nN; const int q = nwg / 8, r = nwg % 8, xcd = wgid % 8, off = wgid / 8;
    wgid = (xcd < r ? xcd * (q + 1) : r * (q + 1) + (xcd - r) * q) + off;
    const int nig = 8 * nN, gid = wgid / nig, fm = gid * 8, gsz = (nM - fm) < 8 ? (nM - fm) : 8;
    pm = fm + ((wgid % nig) % gsz); pn = (wgid % nig) / gsz;
}

template <class Epi, class Sched, bool ALIGN_EPI, bool SP2>
__device__ __forceinline__ void gemm_phase(LAS unsigned char* lds, const Sched& S, const Epi& E) {
    const int tid = threadIdx.x, wid = __builtin_amdgcn_readfirstlane(tid >> 6), lane = tid & 63, wr = wid >> 2, wc = wid & 3, fr = lane & 15, fq = lane >> 4;
    unsigned rA[2], rB[2], c2[2];
#pragma unroll
    for (int i = 0; i < 2; ++i) { int R, C; stage_rc(tid * 16 + i * 8192, R, C); rA[i] = (unsigned)R; rB[i] = (unsigned)(Epi::PERM ? ((R & ~31) + perm32(R & 31)) : R); c2[i] = (unsigned)C * 2u; }
    const size_t kstep = (size_t)(BK * 2);
    const unsigned ldsw = (unsigned)wid * 1024u;
    const int aoff = lds_byte(wr * 64 + fr, fq * 8), boff = lds_byte(wc * 32 + fr, fq * 8);
#define PG8_SA(b, h) (((b) * 2 + (h)) * HTB)
#define PG8_SB(b, h) ((4 + (b) * 2 + (h)) * HTB)
#define PG8_STAGE(bufoff, gbase, ld, RR) do { _Pragma("unroll") for (int _i = 0; _i < 2; ++_i) \
        __builtin_amdgcn_global_load_lds((const unsigned*)((const char*)(gbase) + (size_t)((RR)[_i] * (ld) + c2[_i])), (LAS unsigned*)(lds + (bufoff) + ldsw + _i * 8192), 16, 0, 0); } while (0)
#define PG8_LDA(dst, b, h) do { _Pragma("unroll") for (int m = 0; m < 4; ++m) _Pragma("unroll") for (int k = 0; k < 2; ++k) dst[m][k] = *(const LAS bf16x8*)(lds + PG8_SA(b, h) + aoff + m * 2048 + k * 1024); } while (0)
#define PG8_LDB(dst, b, h) do { _Pragma("unroll") for (int n = 0; n < 2; ++n) _Pragma("unroll") for (int k = 0; k < 2; ++k) dst[n][k] = *(const LAS bf16x8*)(lds + PG8_SB(b, h) + boff + n * 2048 + k * 1024); } while (0)
#define PG8_MMA(ai, bj, At, Bt) do { __builtin_amdgcn_s_setprio(1); _Pragma("unroll") for (int m = 0; m < 4; ++m) _Pragma("unroll") for (int n = 0; n < 2; ++n) _Pragma("unroll") for (int k = 0; k < 2; ++k) \
        acc[ai][bj][m][n] = __builtin_amdgcn_mfma_f32_16x16x32_bf16(Bt[n][k], At[m][k], acc[ai][bj][m][n], 0, 0, 0); __builtin_amdgcn_s_setprio(0); } while (0)
#define PG8_WAIT_V(n) asm volatile("s_waitcnt vmcnt(" #n ")" ::: "memory")
#define PG8_WAIT_L(n) asm volatile("s_waitcnt lgkmcnt(" #n ")" ::: "memory")
#define PG8_BAR __builtin_amdgcn_s_barrier()
#define PG8_SCHED __builtin_amdgcn_sched_barrier(0)
    Unit cur, nxt; int ui = 0;
    if (!S.next(0, cur)) return;
    f32x4 acc[2][2][4][2];
#pragma unroll
    for (int a = 0; a < 2; ++a)
#pragma unroll
        for (int b = 0; b < 2; ++b)
#pragma unroll
            for (int m = 0; m < 4; ++m)
#pragma unroll
                for (int n = 0; n < 2; ++n) acc[a][b][m][n] = (f32x4){0.f, 0.f, 0.f, 0.f};
    bf16x8 At[4][2], B0[2][2], B1[2][2];
    const char* cA = cur.A; const char* cB = cur.B; unsigned cla = cur.lda, clb = cur.ldb;
    {
        const size_t hA = (size_t)HALF * cla, hB = (size_t)HALF * clb;
        if constexpr (SP2) {
            PG8_STAGE(PG8_SB(0, 0), cB, clb, rB); PG8_STAGE(PG8_SB(0, 1), cB + hB, clb, rB); PG8_STAGE(PG8_SA(0, 0), cA, cla, rA); PG8_STAGE(PG8_SA(0, 1), cA + hA, cla, rA);
            if (wr == 1) PG8_BAR;
            PG8_WAIT_V(2); PG8_BAR;
            PG8_STAGE(PG8_SB(1, 0), cB + kstep, clb, rB); PG8_STAGE(PG8_SA(1, 0), cA + kstep, cla, rA); PG8_STAGE(PG8_SB(1, 1), cB + hB + kstep, clb, rB);
            PG8_WAIT_V(6); PG8_BAR;
        } else {
            PG8_STAGE(PG8_SB(0, 0), cB, clb, rB); PG8_STAGE(PG8_SA(0, 0), cA, cla, rA); PG8_STAGE(PG8_SB(0, 1), cB + hB, clb, rB); PG8_STAGE(PG8_SA(0, 1), cA + hA, cla, rA);
            if (wr == 1) PG8_BAR;
            PG8_WAIT_V(4); PG8_BAR;
            PG8_STAGE(PG8_SB(1, 0), cB + kstep, clb, rB); PG8_STAGE(PG8_SA(1, 0), cA + kstep, cla, rA); PG8_STAGE(PG8_SB(1, 1), cB + hB + kstep, clb, rB);
            PG8_WAIT_V(6); PG8_BAR;
        }
    }
    for (;;) {
        const bool has_next = S.next(ui + 1, nxt);
        const char* nA = has_next ? nxt.A : cA; const char* nB = has_next ? nxt.B : cB;
        const unsigned nla = has_next ? nxt.lda : cla, nlb = has_next ? nxt.ldb : clb;
        const int nt = cur.nt;
        const size_t chA = (size_t)HALF * cla;
        for (int t = 0; t < nt; t += 2) {
            const bool last = (t == nt - 2);
            const char* a1 = cA + (size_t)(t + 1) * kstep;
            const char* a2 = last ? nA : cA + (size_t)(t + 2) * kstep; const char* b2 = last ? nB : cB + (size_t)(t + 2) * kstep;
            const unsigned la2 = last ? nla : cla, lb2 = last ? nlb : clb;
            const size_t hA2 = (size_t)HALF * la2, hB2 = (size_t)HALF * lb2;
            const char* a3 = a2 + kstep; const char* b3 = b2 + kstep;
            if constexpr (SP2) {
            PG8_LDB(B0, 0, 0); PG8_LDB(B1, 0, 1); PG8_SCHED; PG8_LDA(At, 0, 0); PG8_STAGE(PG8_SA(1, 1), a1 + chA, cla, rA);
            PG8_WAIT_V(8); PG8_WAIT_L(0); PG8_BAR; PG8_MMA(0, 0, At, B0); PG8_MMA(0, 1, At, B1); PG8_BAR; PG8_SCHED;
            PG8_LDA(At, 0, 1); PG8_STAGE(PG8_SB(0, 0), b2, lb2, rB); PG8_STAGE(PG8_SB(0, 1), b2 + hB2, lb2, rB); PG8_STAGE(PG8_SA(0, 0), a2, la2, rA);
            PG8_WAIT_V(8); PG8_WAIT_L(0); PG8_BAR; PG8_MMA(1, 0, At, B0); PG8_MMA(1, 1, At, B1); PG8_BAR; PG8_SCHED;
            PG8_LDB(B0, 1, 0); PG8_LDB(B1, 1, 1); PG8_SCHED; PG8_LDA(At, 1, 0); PG8_STAGE(PG8_SA(0, 1), a2 + hA2, la2, rA);
            PG8_WAIT_V(8); PG8_WAIT_L(0); PG8_BAR; PG8_MMA(0, 0, At, B0); PG8_MMA(0, 1, At, B1); PG8_BAR; PG8_SCHED;
            PG8_LDA(At, 1, 1); PG8_STAGE(PG8_SB(1, 0), b3, lb2, rB); PG8_STAGE(PG8_SB(1, 1), b3 + hB2, lb2, rB); PG8_STAGE(PG8_SA(1, 0), a3, la2, rA);
            PG8_WAIT_V(8); PG8_WAIT_L(0); PG8_BAR; PG8_MMA(1, 0, At, B0); PG8_MMA(1, 1, At, B1); PG8_BAR; PG8_SCHED;
            } else {
            PG8_LDB(B0, 0, 0); PG8_SCHED; PG8_LDA(At, 0, 0); PG8_STAGE(PG8_SA(1, 1), a1 + chA, cla, rA);
            PG8_WAIT_L(8); PG8_BAR; PG8_WAIT_L(0); PG8_MMA(0, 0, At, B0); PG8_BAR; PG8_SCHED;
            PG8_LDB(B1, 0, 1); PG8_STAGE(PG8_SB(0, 0), b2, lb2, rB);
            PG8_BAR; PG8_WAIT_L(0); PG8_MMA(0, 1, At, B1); PG8_BAR;
            PG8_LDA(At, 0, 1); PG8_STAGE(PG8_SA(0, 0), a2, la2, rA);
            PG8_BAR; PG8_WAIT_L(0); PG8_MMA(1, 0, At, B0); PG8_BAR; PG8_SCHED;
            PG8_STAGE(PG8_SB(0, 1), b2 + hB2, lb2, rB);
            PG8_WAIT_V(6); PG8_BAR; PG8_MMA(1, 1, At, B1); PG8_BAR;
            PG8_LDB(B0, 1, 0); PG8_SCHED; PG8_LDA(At, 1, 0); PG8_STAGE(PG8_SA(0, 1), a2 + hA2, la2, rA);
            PG8_WAIT_L(8); PG8_BAR; PG8_WAIT_L(0); PG8_MMA(0, 0, At, B0); PG8_BAR; PG8_SCHED;
            PG8_LDB(B1, 1, 1); PG8_STAGE(PG8_SB(1, 0), b3, lb2, rB);
            PG8_BAR; PG8_WAIT_L(0); PG8_MMA(0, 1, At, B1); PG8_BAR;
            PG8_LDA(At, 1, 1); PG8_STAGE(PG8_SA(1, 0), a3, la2, rA);
            PG8_BAR; PG8_WAIT_L(0); PG8_MMA(1, 0, At, B0); PG8_BAR; PG8_SCHED;
            PG8_STAGE(PG8_SB(1, 1), b3 + hB2, lb2, rB);
            PG8_WAIT_V(6); PG8_BAR; PG8_MMA(1, 1, At, B1); PG8_BAR;
            }
        }
        if constexpr (ALIGN_EPI) { if (wr == 0) PG8_BAR; }
        { int fr_ = fr, fq_ = fq; asm volatile("" : "+v"(fr_), "+v"(fq_)); E(acc, cur, wr, wc, fr_, fq_); }
        if (!has_next) break;
#pragma unroll
        for (int a = 0; a < 2; ++a)
#pragma unroll
            for (int b = 0; b < 2; ++b)
#pragma unroll
                for (int m = 0; m < 4; ++m)
#pragma unroll
                    for (int n = 0; n < 2; ++n) acc[a][b][m][n] = (f32x4){0.f, 0.f, 0.f, 0.f};
        cur = nxt; cA = nA; cB = nB; cla = nla; clb = nlb; ++ui;
        if constexpr (ALIGN_EPI) { if (wr == 1) PG8_BAR; }
    }
    PG8_WAIT_V(0);
    if constexpr (!ALIGN_EPI) { if (wr == 0) PG8_BAR; }
    PG8_BAR;
#undef PG8_SA
#undef PG8_SB
#undef PG8_STAGE
#undef PG8_LDA
#undef PG8_LDB
#undef PG8_MMA
#undef PG8_WAIT_V
#undef PG8_WAIT_L
#undef PG8_BAR
#undef PG8_SCHED
}

template <class Epi, class Sched>
__device__ __forceinline__ void gemm_phase_naive(LAS unsigned char* lds, const Sched& S, const Epi& E) {
    const int tid = threadIdx.x, wid = tid >> 6, lane = tid & 63, wr = wid >> 2, wc = wid & 3, fr = lane & 15, fq = lane >> 4;
    constexpr int LDP = 72;
    LAS bf16* As = (LAS bf16*)lds; LAS bf16* Bs = As + 256 * LDP;
    Unit u;
    for (int ui = 0; S.next(ui, u); ++ui) {
        f32x4 acc[2][2][4][2];
#pragma unroll
        for (int a = 0; a < 2; ++a)
#pragma unroll
            for (int b = 0; b < 2; ++b)
#pragma unroll
                for (int m = 0; m < 4; ++m)
#pragma unroll
                    for (int n = 0; n < 2; ++n) acc[a][b][m][n] = (f32x4){0.f, 0.f, 0.f, 0.f};
#pragma unroll 1
        for (int kt = 0; kt < u.nt; ++kt) {
            __syncthreads();
            { const int row = tid >> 1, half = tid & 1;
              const u32x4* sa = (const u32x4*)(u.A + (size_t)row * u.lda + (size_t)kt * 128 + half * 64);
              const u32x4* sb = (const u32x4*)(u.B + (size_t)row * u.ldb + (size_t)kt * 128 + half * 64);
#pragma unroll
              for (int j = 0; j < 4; ++j) { *(LAS u32x4*)(As + row * LDP + half * 32 + j * 8) = sa[j]; *(LAS u32x4*)(Bs + row * LDP + half * 32 + j * 8) = sb[j]; } }
            __syncthreads();
#pragma unroll 1
            for (int kk = 0; kk < 8; ++kk) {
#pragma unroll
                for (int ai = 0; ai < 2; ++ai)
#pragma unroll
                    for (int m = 0; m < 4; ++m) {
                        float af[8];
                        { const u32x4 w = *(const LAS u32x4*)(As + (ai * 128 + wr * 64 + m * 16 + fr) * LDP + kk * 8);
                          af[0] = bflo(w.x); af[1] = bfhi(w.x); af[2] = bflo(w.y); af[3] = bfhi(w.y); af[4] = bflo(w.z); af[5] = bfhi(w.z); af[6] = bflo(w.w); af[7] = bfhi(w.w); }
#pragma unroll
                        for (int bj = 0; bj < 2; ++bj)
#pragma unroll
                            for (int n = 0; n < 2; ++n)
#pragma unroll
                                for (int e = 0; e < 4; ++e) {
                                    const int col = bj * 128 + wc * 32 + (Epi::PERM ? (8 * fq + 4 * n + e) : (16 * n + 4 * fq + e));
                                    const u32x4 w = *(const LAS u32x4*)(Bs + col * LDP + kk * 8);
                                    float s = acc[ai][bj][m][n][e];
                                    s = fmaf(af[0], bflo(w.x), s); s = fmaf(af[1], bfhi(w.x), s); s = fmaf(af[2], bflo(w.y), s); s = fmaf(af[3], bfhi(w.y), s);
                                    s = fmaf(af[4], bflo(w.z), s); s = fmaf(af[5], bfhi(w.z), s); s = fmaf(af[6], bflo(w.w), s); s = fmaf(af[7], bfhi(w.w), s);
                                    acc[ai][bj][m][n][e] = s;
                                    asm volatile("" ::: "memory");
                                }
                    }
            }
        }
        { int fr_ = fr, fq_ = fq; asm volatile("" : "+v"(fr_), "+v"(fq_)); E(acc, u, wr, wc, fr_, fq_); }
    }
    __syncthreads();
}
}
using pg8::Unit;

#define XB_TMO      128
#define XB_XCNT(j)  (256  + 64 * (j))
#define XB_XSUB(j)  (1280 + 64 * (j))
#define XB_XGEN(j)  (2304 + 64 * (j))
#define XB_TOP      3328
#define XB_TOPGEN   3392
#define XCD_BAR_WORDS 3456
#define XB_SPIN_CAP (1u << 18)
__device__ __forceinline__ unsigned xb_ld(unsigned* p)              { return __hip_atomic_load(p, __ATOMIC_RELAXED, __HIP_MEMORY_SCOPE_AGENT); }
__device__ __forceinline__ unsigned xb_add(unsigned* p, unsigned v) { return __hip_atomic_fetch_add(p, v, __ATOMIC_RELAXED, __HIP_MEMORY_SCOPE_AGENT); }
__device__ __forceinline__ unsigned xb_xcc_id() { return (unsigned)__builtin_amdgcn_s_getreg((3 << 11) | 20) & 0xFu; }
#define XB_SPIN(cond, bar) do { unsigned _sp = 0; while (cond) { __builtin_amdgcn_s_sleep(1); \
    if ((++_sp & 255u) == 0u) { if (xb_ld(&(bar)[XB_TMO])) break; if (_sp > XB_SPIN_CAP) { atomicAdd(&(bar)[XB_TMO], 1u); break; } } } } while (0)
struct XcdBarrier { unsigned* bar; unsigned x; volatile LAS unsigned* st; };
__device__ __forceinline__ XcdBarrier xcd_barrier_post(unsigned* bar, volatile LAS unsigned* st) {
    XcdBarrier b; b.bar = bar; b.x = xb_xcc_id(); b.st = st;
    if (threadIdx.x == 0) (void)xb_add(&bar[XB_XCNT(b.x)], 1u);
    return b;
}
__device__ __forceinline__ void xcd_barrier_complete(unsigned* bar, unsigned x, unsigned& nloc, unsigned& nx) {
    const unsigned G = gridDim.x * gridDim.y * gridDim.z;
    unsigned sum, cnt, mine, sp = 0u;
    for (;;) {
        sum = 0u; cnt = 0u; mine = 0u;
#pragma unroll
        for (unsigned j = 0; j < 16; ++j) { const unsigned c = xb_ld(&bar[XB_XCNT(j)]); sum += c; cnt += (c > 0u) ? 1u : 0u; mine = (j == x) ? c : mine; }
        if (sum == G) break;
        __builtin_amdgcn_s_sleep(1);
        if ((++sp & 255u) == 0u) { if (xb_ld(&bar[XB_TMO])) break; if (sp > XB_SPIN_CAP) { atomicAdd(&bar[XB_TMO], 1u); break; } }
    }
    nloc = mine > 0u ? mine : 1u; nx = cnt > 0u ? cnt : 1u;
}
__device__ __forceinline__ void xcd_barrier(const XcdBarrier& b) {
    asm volatile("s_waitcnt vmcnt(0)" ::: "memory");
    __syncthreads();
    if (threadIdx.x == 0) {
        unsigned* bar = b.bar;
        __builtin_amdgcn_s_waitcnt(0);
        unsigned nloc = b.st[0], nx = b.st[1];
        if (nloc == 0u) { xcd_barrier_complete(bar, b.x, nloc, nx); b.st[0] = nloc; b.st[1] = nx; }
        const unsigned old = xb_add(&bar[XB_XSUB(b.x)], 1u);
        const unsigned gen = old / nloc;
        if (old + 1u == (gen + 1u) * nloc) {
            __builtin_amdgcn_fence(__ATOMIC_RELEASE, "agent");
            asm volatile("s_waitcnt vmcnt(0)" ::: "memory");
            const unsigned og = xb_add(&bar[XB_TOP], 1u);
            const unsigned tg = og / nx;
            if (og + 1u == (tg + 1u) * nx) xb_add(&bar[XB_TOPGEN], 1u);
            else XB_SPIN(xb_ld(&bar[XB_TOPGEN]) == tg, bar);
            __builtin_amdgcn_fence(__ATOMIC_ACQUIRE, "agent");
            xb_add(&bar[XB_XGEN(b.x)], 1u);
            asm volatile("s_waitcnt vmcnt(0)" ::: "memory");
        } else {
            XB_SPIN(xb_ld(&bar[XB_XGEN(b.x)]) == gen, bar);
            __builtin_amdgcn_fence(__ATOMIC_ACQUIRE, "agent");
            asm volatile("s_waitcnt vmcnt(0)" ::: "memory");
        }
    }
    __syncthreads();
}

constexpr int NWAVES = 8;
constexpr int RING_BYTES = 131072, LDSCTL_OFF = RING_BYTES, MISC_OFF = LDSCTL_OFF + 320, LDS_BYTES = 147456;
struct Args { const float* in[25]; float* out; unsigned char* ws; int ph_lo, ph_hi, flags, li; };
enum { I_X = 0, I_MEM, I_GMIX, I_GMEM, I_GFFN, I_GFINAL, I_WIN, I_WGATE, I_BGATE, I_RPB, I_WMKV, I_ARE, I_AIM, I_LOGDT, I_BRE, I_BIM, I_CRE, I_CIM, I_S5D, I_WGLU, I_WBR, I_WO, I_W1, I_W3, I_W2 };
constexpr int FL_NAIVE_GEMM = 1, FL_NAIVE_S5 = 2;
struct Frame {
    LAS unsigned char* lds; const Args* a; unsigned char* ws;
    int tid, lane, wave, G, gw, NGW;
};

template <int MODE>
__device__ __forceinline__ void p0_transpose_item(const float* W, int N, bf16* WT, int ldt, int row_off, const float* ks, LAS float* scr, int item, int lane) {
    const int nblk = N / 32, kb = item / nblk, nb = item % nblk, k0 = 64 * kb, n0 = 32 * nb;
#pragma unroll 8
    for (int i = 0; i < 32; ++i) { const int kk = 2 * i + (lane >> 5); float v = W[(size_t)(k0 + kk) * N + n0 + (lane & 31)]; if (ks) v *= ks[k0 + kk]; scr[kk * 33 + (lane & 31)] = v; }
    asm volatile("s_waitcnt lgkmcnt(0)" ::: "memory");
    const int c = lane & 7;
#pragma unroll
    for (int j = 0; j < 4; ++j) { const int n = (lane >> 3) + 8 * j; const LAS float* s = scr + (8 * c) * 33 + n;
        u32x4 o; o.x = pk2(s[0 * 33], s[1 * 33]); o.y = pk2(s[2 * 33], s[3 * 33]); o.z = pk2(s[4 * 33], s[5 * 33]); o.w = pk2(s[6 * 33], s[7 * 33]);
        const int nn = n0 + n; const int row = MODE == 0 ? (row_off + nn) : (32 * (nn >> 4) + (nn & 15) + row_off);
        *(u32x4*)(WT + (size_t)row * ldt + k0 + 8 * c) = o; }
    asm volatile("s_waitcnt lgkmcnt(0)" ::: "memory");
}
__device__ __forceinline__ void rms_row_to_bf16(const float* xrow, const float* g, bf16* orow, int lane) {
    const f32x4* xr = (const f32x4*)xrow + lane; const f32x4* gr = (const f32x4*)g + lane;
    f32x4 v[4]; float s = 0.f;
#pragma unroll
    for (int j = 0; j < 4; ++j) { v[j] = xr[64 * j]; s += (v[j].x * v[j].x + v[j].y * v[j].y) + (v[j].z * v[j].z + v[j].w * v[j].w); }
    const float rstd = 1.0f / sqrtf(wave_sum(s) * (1.f / 1024.f) + EPS);
    u32x2* o8 = (u32x2*)orow + lane;
#pragma unroll
    for (int j = 0; j < 4; ++j) { const f32x4 gg = gr[64 * j]; u32x2 w; w.x = pk2(v[j].x * rstd * gg.x, v[j].y * rstd * gg.y); w.y = pk2(v[j].z * rstd * gg.z, v[j].w * rstd * gg.w); o8[64 * j] = w; }
}
__device__ __forceinline__ f32x2 s5_cpow(float lr, float li, float dtv, int k) {
    const float mag = __expf((float)k * lr * dtv);
    double rev = (double)k * (double)li * (double)dtv * 0.15915494309189535;
    rev -= rint(rev);
    const float fr = (float)rev;
    return (f32x2){mag * __builtin_amdgcn_cosf(fr), mag * __builtin_amdgcn_sinf(fr)};
}
__device__ __forceinline__ f32x2 cmul(f32x2 a, f32x2 b) { return (f32x2){a.x * b.x - a.y * b.y, a.x * b.y + a.y * b.x}; }
__device__ __forceinline__ f32x2 s5_q(float lr, float li, float dtv) {
    const f32x2 lb = s5_cpow(lr, li, dtv, 1);
    const float nx = lb.x - 1.f, ny = lb.y, inv = 1.f / (lr * lr + li * li);
    return (f32x2){(nx * lr + ny * li) * inv, (ny * lr - nx * li) * inv};
}

__device__ __forceinline__ void p0_prologue(Frame& F) {
    const Args& A = *F.a; unsigned char* ws = F.ws; const int lane = F.lane;
    LAS float* scr = (LAS float*)(F.lds + F.wave * 16384);
    constexpr int I_IN = 16 * (NIN / 32), I_G = 16 * (3072 / 32), I_UP = 8 * 32, I_O = 16 * 32, I_GLU = 8 * 16, I_MKV = 16 * 32, I_F = 16 * (DFF / 32), I_2 = (DFF / 64) * 32;
    constexpr int NITEMS = I_IN + I_G + 3 * I_UP + I_O + I_GLU + I_MKV + 2 * I_F + I_2;
    for (int it = F.gw; it < NITEMS; it += F.NGW) {
        int r = it;
        if (r < I_IN) { p0_transpose_item<0>(A.in[I_WIN], NIN, (bf16*)(ws + WS_WIN), 1024, 0, nullptr, scr, r, lane); continue; } r -= I_IN;
        if (r < I_G) { p0_transpose_item<0>(A.in[I_WGATE], 3072, (bf16*)(ws + WS_WG), 1024, 0, nullptr, scr, r, lane); continue; } r -= I_G;
        if (r < 3 * I_UP) { const int b = r / I_UP; p0_transpose_item<0>(A.in[I_WBR] + (size_t)b * 512 * 1024, 1024, (bf16*)(ws + WS_WUP), 512, b * 1024, nullptr, scr, r % I_UP, lane); continue; } r -= 3 * I_UP;
        if (r < I_O) { p0_transpose_item<0>(A.in[I_WO], 1024, (bf16*)(ws + WS_WO), 1024, 0, nullptr, scr, r, lane); continue; } r -= I_O;
        if (r < I_GLU) { p0_transpose_item<0>(A.in[I_WGLU], 512, (bf16*)(ws + WS_WGLU), 512, 0, nullptr, scr, r, lane); continue; } r -= I_GLU;
        if (r < I_MKV) { p0_transpose_item<0>(A.in[I_WMKV], 1024, (bf16*)(ws + WS_WMKV), 1024, 0, nullptr, scr, r, lane); continue; } r -= I_MKV;
        if (r < I_F) { p0_transpose_item<1>(A.in[I_W1], DFF, (bf16*)(ws + WS_W13), 1024, 0, A.in[I_GFFN], scr, r, lane); continue; } r -= I_F;
        if (r < I_F) { p0_transpose_item<1>(A.in[I_W3], DFF, (bf16*)(ws + WS_W13), 1024, 16, A.in[I_GFFN], scr, r, lane); continue; } r -= I_F;
        p0_transpose_item<0>(A.in[I_W2], 1024, (bf16*)(ws + WS_W2), DFF, 0, nullptr, scr, r, lane);
    }
    for (int m = F.gw; m < T + 1024; m += F.NGW) {
        if (m < T) rms_row_to_bf16(A.in[I_X] + (size_t)m * D, A.in[I_GMIX], (bf16*)(ws + WS_H) + (size_t)m * D, lane);
        else rms_row_to_bf16(A.in[I_MEM] + (size_t)(m - T) * D, A.in[I_GMEM], (bf16*)(ws + WS_MEMN) + (size_t)(m - T) * D, lane);
    }
    const float *a_re = A.in[I_ARE], *a_im = A.in[I_AIM], *log_dt = A.in[I_LOGDT], *b_re = A.in[I_BRE], *b_im = A.in[I_BIM], *c_re = A.in[I_CRE], *c_im = A.in[I_CIM];
    for (int it = F.gw; it < 32 * 256; it += F.NGW) {
        const int g = it >> 8, n = it & 255, dir = n >> 7, comp = (n >> 6) & 1, p = n & 63;
        const int pi = (dir * 32 + g) * 64 + p; const float lr = a_re[pi], li = a_im[pi], dtv = expf(log_dt[dir * 32 + g]);
        const int j = lane >> 1, ci0 = (lane & 1) * 8;
        const f32x2 coef = cmul(s5_cpow(lr, li, dtv, dir == 0 ? (CL - 1 - j) : j), s5_q(lr, li, dtv));
        float o[8];
#pragma unroll
        for (int i = 0; i < 8; ++i) { const f32x2 bb = (f32x2){b_re[(size_t)pi * 16 + ci0 + i], b_im[(size_t)pi * 16 + ci0 + i]}; const f32x2 v = cmul(coef, bb); o[i] = comp ? v.y : v.x; }
        u32x4 w; w.x = pk2(o[0], o[1]); w.y = pk2(o[2], o[3]); w.z = pk2(o[4], o[5]); w.w = pk2(o[6], o[7]);
        *(u32x4*)((bf16*)(ws + WS_WEND) + ((size_t)(g * 256 + n)) * 512 + lane * 8) = w;
    }
    for (int it = F.gw; it < 32 * 512; it += F.NGW) {
        const int g = it >> 9, n = it & 511, t = n >> 4, co = n & 15;
        const int dir = lane >> 5, comp = (lane >> 4) & 1, p0 = (lane & 15) * 4;
        const float dtv = expf(log_dt[dir * 32 + g]);
        float o[4];
#pragma unroll
        for (int i = 0; i < 4; ++i) { const int p = p0 + i, pi = (dir * 32 + g) * 64 + p;
            const f32x2 w = s5_cpow(a_re[pi], a_im[pi], dtv, dir == 0 ? (t + 1) : (CL - t));
            const int cidx = ((dir * 32 + g) * 16 + co) * 64 + p; const f32x2 v = cmul((f32x2){c_re[cidx], c_im[cidx]}, w); o[i] = comp ? -v.y : v.x; }
        u32x2 w2; w2.x = pk2(o[0], o[1]); w2.y = pk2(o[2], o[3]);
        *(u32x2*)((bf16*)(ws + WS_WTOEP) + ((size_t)(g * 512 + n)) * U2K + 512 + lane * 4) = w2;
    }
    {
        LAS f32x2* vs = (LAS f32x2*)scr;
        for (int it = F.gw; it < 32 * 2 * 32; it += F.NGW) {
            const int g = it >> 6, dir = (it >> 5) & 1, lag = it & 31, p = lane;
            const int pi = (dir * 32 + g) * 64 + p; const float lr = a_re[pi], li = a_im[pi], dtv = expf(log_dt[dir * 32 + g]);
            const f32x2 coef = cmul(s5_cpow(lr, li, dtv, lag), s5_q(lr, li, dtv));
#pragma unroll
            for (int ci = 0; ci < 16; ++ci) vs[p * 16 + ci] = cmul(coef, (f32x2){b_re[(size_t)pi * 16 + ci], b_im[(size_t)pi * 16 + ci]});
            asm volatile("s_waitcnt lgkmcnt(0)" ::: "memory");
            const int co = lane >> 2, cib = (lane & 3) * 4; float s[4] = {0.f, 0.f, 0.f, 0.f};
            const float* cr = c_re + ((size_t)((dir * 32 + g) * 16 + co)) * 64; const float* cim = c_im + ((size_t)((dir * 32 + g) * 16 + co)) * 64;
            for (int pp = 0; pp < 64; ++pp) { const float x = cr[pp], y = cim[pp];
#pragma unroll
                for (int i = 0; i < 4; ++i) { const f32x2 v = vs[pp * 16 + cib + i]; s[i] += x * v.x - y * v.y; } }
            *(f32x4*)((float*)(ws + WS_KT) + (size_t)it * 256 + lane * 4) = (f32x4){s[0], s[1], s[2], s[3]};
            asm volatile("s_waitcnt lgkmcnt(0)" ::: "memory");
        }
    }
}
__device__ __forceinline__ void p1_toeplitz(Frame& F) {
    const Args& A = *F.a; unsigned char* ws = F.ws; const int lane = F.lane;
    const float* KT = (const float*)(ws + WS_KT); const float* dsk = A.in[I_S5D];
    for (int it = F.gw; it < 32 * 512; it += F.NGW) {
        const int g = it >> 9, n = it & 511, t = n >> 4, co = n & 15, j = lane >> 1, ci0 = (lane & 1) * 8;
        float o[8];
        if (t != j) { const int dir = t > j ? 0 : 1, lag = t > j ? t - j : j - t; const f32x4* s = (const f32x4*)(KT + ((size_t)((g * 2 + dir) * 32 + lag)) * 256 + co * 16 + ci0);
            const f32x4 a = s[0], b = s[1]; o[0] = a.x; o[1] = a.y; o[2] = a.z; o[3] = a.w; o[4] = b.x; o[5] = b.y; o[6] = b.z; o[7] = b.w; }
        else { const f32x4* s0 = (const f32x4*)(KT + ((size_t)((g * 2 + 0) * 32)) * 256 + co * 16 + ci0); const f32x4* s1 = (const f32x4*)(KT + ((size_t)((g * 2 + 1) * 32)) * 256 + co * 16 + ci0);
            const f32x4 a = s0[0] + s1[0], b = s0[1] + s1[1]; o[0] = a.x; o[1] = a.y; o[2] = a.z; o[3] = a.w; o[4] = b.x; o[5] = b.y; o[6] = b.z; o[7] = b.w;
            const float dv = dsk[g * 16 + co];
#pragma unroll
            for (int i = 0; i < 8; ++i) if (ci0 + i == co) o[i] += dv; }
        u32x4 w; w.x = pk2(o[0], o[1]); w.y = pk2(o[2], o[3]); w.z = pk2(o[4], o[5]); w.w = pk2(o[6], o[7]);
        *(u32x4*)((bf16*)(ws + WS_WTOEP) + ((size_t)(g * 512 + n)) * U2K + lane * 8) = w;
    }
}

#define EPI_FOR  _Pragma("unroll") for (int ai = 0; ai < 2; ++ai) _Pragma("unroll") for (int m = 0; m < 4; ++m) _Pragma("unroll") for (int bj = 0; bj < 2; ++bj) _Pragma("unroll") for (int n = 0; n < 2; ++n)
#define EPI_ROW  (u.pm * 256 + ai * 128 + wr * 64 + m * 16 + fr)
#define EPI_COL  (u.pn * 256 + bj * 128 + wc * 32 + n * 16 + fq * 4)
__device__ __forceinline__ u32x2 pack4(f32x4 v) { u32x2 w; w.x = cvt_pk_bf16(v.x, v.y); w.y = cvt_pk_bf16(v.z, v.w); return w; }

struct SchedP1 { int G, c; const char *H, *WIN, *MEMN, *WMKV;
    __device__ __forceinline__ bool next(int i, Unit& u) const {
        const int L = i * G + c; if (L >= 656) return false;
        if (L < 640) { int pm, pn; pg8::tile_order(L, 64, 10, pm, pn); u.A = H + (size_t)pm * 256 * 2048; u.B = WIN + (size_t)pn * 256 * 2048; u.kind = pn >> 1; u.pm = pm; u.pn = pn; }
        else { const int l = L - 640, pm = l >> 2, pn = l & 3; u.A = MEMN + (size_t)pm * 256 * 2048; u.B = WMKV + (size_t)pn * 256 * 2048; u.kind = 5; u.pm = pm; u.pn = pn; }
        u.lda = 2048; u.ldb = 2048; u.nt = 16; return true; } };
struct EpiP1 { static constexpr bool PERM = false; unsigned char* ws;
    __device__ __forceinline__ void operator()(const f32x4 (&acc)[2][2][4][2], const Unit& u, int wr, int wc, int fr, int fq) const {
        EPI_FOR { const int row = EPI_ROW, col = EPI_COL; const u32x2 w = pack4(acc[ai][bj][m][n]); bf16* dst;
            if (u.kind <= 2) dst = (bf16*)(ws + WS_Q + (size_t)u.kind * (WS_K - WS_Q)) + (size_t)row * 512 + (col - u.kind * 512);
            else if (u.kind == 3) { const int cl = col - 1536, g = cl >> 4, ci = cl & 15, b = row >> 12, s = row & 4095, c = s >> 5, t = s & 31;
                dst = (bf16*)(ws + WS_U2) + ((size_t)(g * NCR + b * NCH + c)) * U2K + t * 16 + ci; }
            else if (u.kind == 4) dst = (bf16*)(ws + WS_QM) + (size_t)row * 512 + (col - 2048);
            else dst = (bf16*)(ws + WS_KVM) + (size_t)row * 1024 + col;
            *(u32x2*)dst = w; }
    } };
struct SchedC1 { int c; const char *U2, *WEND;
    __device__ __forceinline__ bool next(int i, Unit& u) const {
        if (i > 0 || c >= 64) return false; const int g = c >> 1, pm = c & 1;
        u.A = U2 + ((size_t)(g * NCR + pm * 256)) * U2K * 2; u.B = WEND + (size_t)g * 256 * 512 * 2; u.lda = U2K * 2; u.ldb = 1024; u.nt = 8; u.kind = g; u.pm = pm; u.pn = 0; return true; } };
struct EpiC1 { static constexpr bool PERM = false; unsigned char* ws;
    __device__ __forceinline__ void operator()(const f32x4 (&acc)[2][2][4][2], const Unit& u, int wr, int wc, int fr, int fq) const {
        EPI_FOR { const int row = EPI_ROW, col = EPI_COL; *(f32x4*)((float*)(ws + WS_SLOC) + ((size_t)(u.kind * NCR + row)) * 256 + col) = acc[ai][bj][m][n]; }
    } };
struct SchedC3 { int c; const char *U2, *WT;
    __device__ __forceinline__ bool next(int i, Unit& u) const {
        if (i > 0 || c >= 128) return false; const int g = c >> 2, pm = (c >> 1) & 1, pn = c & 1;
        u.A = U2 + ((size_t)(g * NCR + pm * 256)) * U2K * 2; u.B = WT + ((size_t)(g * 512 + pn * 256)) * U2K * 2; u.lda = U2K * 2; u.ldb = U2K * 2; u.nt = 12; u.kind = g; u.pm = pm; u.pn = pn; return true; } };
struct EpiC3 { static constexpr bool PERM = false; unsigned char* ws;
    __device__ __forceinline__ void operator()(const f32x4 (&acc)[2][2][4][2], const Unit& u, int wr, int wc, int fr, int fq) const {
        EPI_FOR { const int row = EPI_ROW, col = EPI_COL; const int b = row >> 7, c = row & 127, t = col >> 4, co = col & 15;
            f32x4 v = acc[ai][bj][m][n]; v.x = gelu_tanh(v.x); v.y = gelu_tanh(v.y); v.z = gelu_tanh(v.z); v.w = gelu_tanh(v.w);
            *(u32x2*)((bf16*)(ws + WS_Z) + ((size_t)(b * SEQ + c * CL + t)) * 512 + u.kind * 16 + co) = pack4(v); }
    } };
struct SchedP5 { int c; const char *Z, *WGLU;
    __device__ __forceinline__ bool next(int i, Unit& u) const {
        if (i > 0 || c >= 128) return false; int pm, pn; pg8::tile_order(c, 64, 2, pm, pn);
        u.A = Z + (size_t)pm * 256 * 1024; u.B = WGLU + (size_t)pn * 256 * 1024; u.lda = 1024; u.ldb = 1024; u.nt = 8; u.kind = 0; u.pm = pm; u.pn = pn; return true; } };
struct EpiP5 { static constexpr bool PERM = false; unsigned char* ws;
    __device__ __forceinline__ void operator()(const f32x4 (&acc)[2][2][4][2], const Unit& u, int wr, int wc, int fr, int fq) const {
        EPI_FOR { const int row = EPI_ROW, col = EPI_COL; const u32x2 zz = *(const u32x2*)((const bf16*)(ws + WS_Z) + (size_t)row * 512 + col);
            f32x4 v = acc[ai][bj][m][n]; v.x = bflo(zz.x) * sigmoidf_(v.x); v.y = bfhi(zz.x) * sigmoidf_(v.y); v.z = bflo(zz.y) * sigmoidf_(v.z); v.w = bfhi(zz.y) * sigmoidf_(v.w);
            *(u32x2*)((bf16*)(ws + WS_YS5) + (size_t)row * 512 + col) = pack4(v); }
    } };
struct SchedP6 { int pm, pn; const char* ws;
    __device__ __forceinline__ bool next(int i, Unit& u) const {
        if (i >= 6) return false; const int b = i >> 1;
        if ((i & 1) == 0) { u.A = ws + WS_H + (size_t)pm * 256 * 2048; u.B = ws + WS_WG + ((size_t)(b * 1024 + pn * 256)) * 2048; u.lda = 2048; u.ldb = 2048; u.nt = 16; }
        else { const size_t yo = b == 0 ? WS_Q : (b == 1 ? WS_YS5 : WS_QM); u.A = ws + yo + (size_t)pm * 256 * 1024; u.B = ws + WS_WUP + ((size_t)(b * 1024 + pn * 256)) * 1024; u.lda = 1024; u.ldb = 1024; u.nt = 8; }
        u.kind = i; u.pm = pm; u.pn = pn; return true; } };
struct EpiP6 { static constexpr bool PERM = false; unsigned char* ws; float* part; const float* bgate;
    __device__ __forceinline__ void operator()(const f32x4 (&acc)[2][2][4][2], const Unit& u, int wr, int wc, int fr, int fq) const {
        const int b = u.kind >> 1; int tid = threadIdx.x; asm volatile("" : "+v"(tid));
        u32x2* gs = (u32x2*)(ws + WS_G) + (size_t)blockIdx.x * (32 * 512) + tid; f32x4* ps = (f32x4*)part + tid;
        if ((u.kind & 1) == 0) {
            EPI_FOR { const int col = EPI_COL; const f32x4 bv = *(const f32x4*)(bgate + b * 1024 + col); f32x4 v = acc[ai][bj][m][n] + bv;
                v.x = sigmoidf_(v.x); v.y = sigmoidf_(v.y); v.z = sigmoidf_(v.z); v.w = sigmoidf_(v.w);
                gs[(((ai * 2 + bj) * 4 + m) * 2 + n) * 512] = pack4(v); }
        } else {
#pragma unroll
            for (int ai = 0; ai < 2; ++ai)
#pragma unroll
                for (int m = 0; m < 4; ++m) {
#pragma unroll
                    for (int bj = 0; bj < 2; ++bj)
#pragma unroll
                        for (int n = 0; n < 2; ++n) { const int slot = ((ai * 2 + bj) * 4 + m) * 2 + n; const u32x2 gg = gs[slot * 512];
                            f32x4 v = acc[ai][bj][m][n]; v.x *= bflo(gg.x); v.y *= bfhi(gg.x); v.z *= bflo(gg.y); v.w *= bfhi(gg.y);
                            if (b > 0) v += ps[slot * 512];
                            if (b < 2) ps[slot * 512] = v;
                            else { const int row = EPI_ROW, col = EPI_COL; *(u32x2*)((bf16*)(ws + WS_MERGED) + (size_t)row * 1024 + col) = pack4(v); } }
                    asm volatile("" ::: "memory"); }
        }
    } };
struct SchedP7 { int c; const char *A0, *B0; unsigned lda, ldb; int nt;
    __device__ __forceinline__ bool next(int i, Unit& u) const {
        if (i > 0) return false; int pm, pn; pg8::tile_order(c, 64, 4, pm, pn);
        u.A = A0 + (size_t)pm * 256 * lda; u.B = B0 + (size_t)pn * 256 * ldb; u.lda = lda; u.ldb = ldb; u.nt = nt; u.kind = 0; u.pm = pm; u.pn = pn; return true; } };
template <bool WRITE_BF>
struct EpiRes { static constexpr bool PERM = false; const float* base; float* out; bf16* xb; float* ss;
    __device__ __forceinline__ void operator()(const f32x4 (&acc)[2][2][4][2], const Unit& u, int wr, int wc, int fr, int fq) const {
#pragma unroll
        for (int ai = 0; ai < 2; ++ai)
#pragma unroll
            for (int m = 0; m < 4; ++m) { const int row = EPI_ROW; float s = 0.f;
#pragma unroll
                for (int bj = 0; bj < 2; ++bj)
#pragma unroll
                    for (int n = 0; n < 2; ++n) { const int col = EPI_COL; const size_t off = (size_t)row * 1024 + col;
                        const f32x4 v = *(const f32x4*)(base + off) + acc[ai][bj][m][n]; *(f32x4*)(out + off) = v; s += (v.x * v.x + v.y * v.y) + (v.z * v.z + v.w * v.w);
                        if (WRITE_BF) *(u32x2*)(xb + off) = pack4(v); }
                s += __shfl_xor(s, 16); s += __shfl_xor(s, 32);
                if (fq == 0) unsafeAtomicAdd(ss + row, s); }
    } };
struct SchedP8 { int G, c; const char *X1B, *W13;
    __device__ __forceinline__ bool next(int i, Unit& u) const {
        const int L = i * G + c; if (L >= 64 * 22) return false; int pm, pn; pg8::tile_order(L, 64, 22, pm, pn);
        u.A = X1B + (size_t)pm * 256 * 2048; u.B = W13 + (size_t)pn * 256 * 2048; u.lda = 2048; u.ldb = 2048; u.nt = 16; u.kind = 0; u.pm = pm; u.pn = pn; return true; } };
struct EpiP8 { static constexpr bool PERM = false; unsigned char* ws;
    __device__ __forceinline__ void operator()(const f32x4 (&acc)[2][2][4][2], const Unit& u, int wr, int wc, int fr, int fq) const {
        const float* ss = (const float*)(ws + WS_SS1);
#pragma unroll
        for (int ai = 0; ai < 2; ++ai)
#pragma unroll
            for (int m = 0; m < 4; ++m) { const int row = EPI_ROW; const float rstd = 1.0f / sqrtf(ss[row] * (1.f / 1024.f) + EPS);
#pragma unroll
                for (int bj = 0; bj < 2; ++bj) { const f32x4 a = acc[ai][bj][m][0] * rstd, b = acc[ai][bj][m][1] * rstd; f32x4 v;
                    v.x = a.x * sigmoidf_(a.x) * b.x; v.y = a.y * sigmoidf_(a.y) * b.y; v.z = a.z * sigmoidf_(a.z) * b.z; v.w = a.w * sigmoidf_(a.w) * b.w;
                    *(u32x2*)((bf16*)(ws + WS_TT) + (size_t)row * DFF + u.pn * 128 + bj * 64 + wc * 16 + fq * 4) = pack4(v); } }
    } };

template <bool NAIVE, class Epi, class Sched, bool MULTI>
__device__ __forceinline__ void run_gemm_(Frame& F, const Sched& S, const Epi& E) {
    if constexpr (NAIVE) pg8::gemm_phase_naive<Epi, Sched>(F.lds, S, E);
    else pg8::gemm_phase<Epi, Sched, MULTI, true>(F.lds, S, E);
}
#define run_gemm run_gemm_<NAIVE_GEMM,

__device__ __forceinline__ void p2_na_simple(Frame& F) {
    unsigned char* ws = F.ws; const int lane = F.lane; const float* rpb = F.a->in[I_RPB];
    const bf16* Q = (const bf16*)(ws + WS_Q); const bf16* K = (const bf16*)(ws + WS_K); const bf16* V = (const bf16*)(ws + WS_V); bf16* Y = (bf16*)(ws + WS_Q);
    LAS float* pl = (LAS float*)(F.lds + F.wave * 1024);
    for (int it = F.gw; it < T * 8; it += F.NGW) {
        const int token = it >> 3, h = it & 7, b = token >> 12, s = token & 4095, r = s >> 6, c = s & 63;
        const int rs = min(max(r - 4, 0), 56), cs = min(max(c - 8, 0), 48);
        const u32x4* qp = (const u32x4*)(Q + (size_t)token * 512 + h * 64);
        float sc[2];
#pragma unroll
        for (int e = 0; e < 2; ++e) { const int kk = lane * 2 + e, i = kk >> 4, w = kk & 15, kt = (b << 12) + ((rs + i) << 6) + cs + w;
            const u32x4* kp = (const u32x4*)(K + (size_t)kt * 512 + h * 64); float d = 0.f;
#pragma unroll
            for (int j = 0; j < 8; ++j) { const u32x4 a = qp[j], k4 = kp[j];
                d += bflo(a.x) * bflo(k4.x) + bfhi(a.x) * bfhi(k4.x) + bflo(a.y) * bflo(k4.y) + bfhi(a.y) * bfhi(k4.y) + bflo(a.z) * bflo(k4.z) + bfhi(a.z) * bfhi(k4.z) + bflo(a.w) * bflo(k4.w) + bfhi(a.w) * bfhi(k4.w); }
            const int rr = rs + i - r + 7, rc = min(max(cs + w - c + 15, 0), 30);
            sc[e] = d * 0.125f + rpb[(h * 15 + rr) * 31 + rc]; }
        const float mx = wave_max(fmaxf(sc[0], sc[1])); const float p0 = __expf(sc[0] - mx), p1 = __expf(sc[1] - mx); const float l = wave_sum(p0 + p1);
        pl[lane * 2] = p0; pl[lane * 2 + 1] = p1;
        asm volatile("s_waitcnt lgkmcnt(0)" ::: "memory");
        float o = 0.f;
        for (int kk = 0; kk < 128; ++kk) { const int i = kk >> 4, w = kk & 15, kt = (b << 12) + ((rs + i) << 6) + cs + w; o += pl[kk] * bf2f(V[(size_t)kt * 512 + h * 64 + lane]); }
        Y[(size_t)token * 512 + h * 64 + lane] = (bf16)f2bf(o / l);
        asm volatile("s_waitcnt lgkmcnt(0)" ::: "memory");
    }
}
__device__ __forceinline__ void p2_mem_simple(Frame& F) {
    unsigned char* ws = F.ws; const int lane = F.lane;
    const bf16* QM = (const bf16*)(ws + WS_QM); const bf16* KVM = (const bf16*)(ws + WS_KVM); bf16* Y = (bf16*)(ws + WS_QM);
    LAS float* pl = (LAS float*)(F.lds + 8192 + F.wave * 1024);
    for (int it = F.gw; it < T * 4; it += F.NGW) {
        const int token = it >> 2, h = it & 3, b = token >> 12;
        const u32x4* qp = (const u32x4*)(QM + (size_t)token * 512 + h * 128);
        float sc[4];
#pragma unroll
        for (int e = 0; e < 4; ++e) { const int mm = lane * 4 + e; const u32x4* kp = (const u32x4*)(KVM + ((size_t)(b * 256 + mm)) * 1024 + h * 128); float d = 0.f;
#pragma unroll
            for (int j = 0; j < 16; ++j) { const u32x4 a = qp[j], k4 = kp[j];
                d += bflo(a.x) * bflo(k4.x) + bfhi(a.x) * bfhi(k4.x) + bflo(a.y) * bflo(k4.y) + bfhi(a.y) * bfhi(k4.y) + bflo(a.z) * bflo(k4.z) + bfhi(a.z) * bfhi(k4.z) + bflo(a.w) * bflo(k4.w) + bfhi(a.w) * bfhi(k4.w); }
            sc[e] = d * 0.08838834764831845f; }
        const float mx = wave_max(fmaxf(fmaxf(sc[0], sc[1]), fmaxf(sc[2], sc[3])));
        float p[4]; float ls = 0.f;
#pragma unroll
        for (int e = 0; e < 4; ++e) { p[e] = __expf(sc[e] - mx); ls += p[e]; pl[lane * 4 + e] = p[e]; }
        const float l = wave_sum(ls);
        asm volatile("s_waitcnt lgkmcnt(0)" ::: "memory");
        float o0 = 0.f, o1 = 0.f;
        for (int mm = 0; mm < 256; ++mm) { const unsigned vv = *(const unsigned*)(KVM + ((size_t)(b * 256 + mm)) * 1024 + 512 + h * 128 + lane * 2); const float pp = pl[mm]; o0 += pp * bflo(vv); o1 += pp * bfhi(vv); }
        *(unsigned*)(Y + (size_t)token * 512 + h * 128 + lane * 2) = pk2(o0 / l, o1 / l);
        asm volatile("s_waitcnt lgkmcnt(0)" ::: "memory");
    }
}
__device__ __forceinline__ void p3_carry(Frame& F) {
    if (F.wave != 0) return;
    unsigned char* ws = F.ws; const Args& A = *F.a; const int item = blockIdx.x; if (item >= 256) return;
    const int g = item >> 3, dir = (item >> 2) & 1, b = item & 3, p = F.lane;
    const int pi = (dir * 32 + g) * 64 + p; const f32x2 lamL = s5_cpow(A.in[I_ARE][pi], A.in[I_AIM][pi], expf(A.in[I_LOGDT][dir * 32 + g]), CL);
    const float* sl = (const float*)(ws + WS_SLOC) + ((size_t)(g * NCR + b * NCH)) * 256 + dir * 128 + p;
    bf16* u2 = (bf16*)(ws + WS_U2) + ((size_t)(g * NCR + b * NCH)) * U2K + 512 + dir * 128 + p;
    f32x2 S = (f32x2){0.f, 0.f};
    for (int c0 = 0; c0 < NCH; c0 += 16) {
        float re[16], im[16];
#pragma unroll
        for (int j = 0; j < 16; ++j) { const int c = dir == 0 ? (c0 + j) : (NCH - 1 - c0 - j); re[j] = sl[(size_t)c * 256]; im[j] = sl[(size_t)c * 256 + 64]; }
#pragma unroll
        for (int j = 0; j < 16; ++j) { const int c = dir == 0 ? (c0 + j) : (NCH - 1 - c0 - j);
            u2[(size_t)c * U2K] = (bf16)f2bf(S.x); u2[(size_t)c * U2K + 64] = (bf16)f2bf(S.y);
            const f32x2 ns = cmul(lamL, S); S = (f32x2){ns.x + re[j], ns.y + im[j]}; }
    }
}
__device__ __forceinline__ void p4_s5_direct(Frame& F) {
    if (F.wave != 0 || blockIdx.x >= 128) return;
    unsigned char* ws = F.ws; const Args& A = *F.a; const int lane = F.lane;
    const int b = blockIdx.x >> 5, g = blockIdx.x & 31, p = lane;
    float* yscr = F.a->out; const bf16* U2 = (const bf16*)(ws + WS_U2); bf16* Z = (bf16*)(ws + WS_Z);
    for (int dir = 0; dir < 2; ++dir) {
        const int pi = (dir * 32 + g) * 64 + p; const float lr = A.in[I_ARE][pi], li = A.in[I_AIM][pi], dtv = expf(A.in[I_LOGDT][dir * 32 + g]);
        const f32x2 lb = s5_cpow(lr, li, dtv, 1), q = s5_q(lr, li, dtv);
        f32x2 bb[16], cm[16];
#pragma unroll
        for (int ci = 0; ci < 16; ++ci) { bb[ci] = cmul(q, (f32x2){A.in[I_BRE][(size_t)pi * 16 + ci], A.in[I_BIM][(size_t)pi * 16 + ci]});
            const int cidx = ((dir * 32 + g) * 16 + ci) * 64 + p; cm[ci] = (f32x2){A.in[I_CRE][cidx], A.in[I_CIM][cidx]}; }
        f32x2 s = (f32x2){0.f, 0.f};
        const int myco = (lane >> 2) & 15; const float dsk = A.in[I_S5D][g * 16 + myco];
        for (int step = 0; step < SEQ; ++step) {
            const int t = dir == 0 ? step : SEQ - 1 - step;
            const bf16* up = U2 + ((size_t)(g * NCR + b * NCH + (t >> 5))) * U2K + (t & 31) * 16;
            const u32x4 w0 = ((const u32x4*)up)[0], w1 = ((const u32x4*)up)[1];
            float uu[16]; uu[0] = bflo(w0.x); uu[1] = bfhi(w0.x); uu[2] = bflo(w0.y); uu[3] = bfhi(w0.y); uu[4] = bflo(w0.z); uu[5] = bfhi(w0.z); uu[6] = bflo(w0.w); uu[7] = bfhi(w0.w);
            uu[8] = bflo(w1.x); uu[9] = bfhi(w1.x); uu[10] = bflo(w1.y); uu[11] = bfhi(w1.y); uu[12] = bflo(w1.z); uu[13] = bfhi(w1.z); uu[14] = bflo(w1.w); uu[15] = bfhi(w1.w);
            f32x2 bu = (f32x2){0.f, 0.f};
#pragma unroll
            for (int ci = 0; ci < 16; ++ci) { bu.x += bb[ci].x * uu[ci]; bu.y += bb[ci].y * uu[ci]; }
            const f32x2 ns = cmul(lb, s); s = (f32x2){ns.x + bu.x, ns.y + bu.y};
            float v16[16];
#pragma unroll
            for (int co = 0; co < 16; ++co) v16[co] = cm[co].x * s.x - cm[co].y * s.y;
            const bool h1 = (lane >> 5) & 1, h2 = (lane >> 4) & 1, h3 = (lane >> 3) & 1, h4 = (lane >> 2) & 1;
            float v8[8], v4[4], v2[2], v1;
#pragma unroll
            for (int i = 0; i < 8; ++i) { const float snd = h1 ? v16[i] : v16[8 + i], kp = h1 ? v16[8 + i] : v16[i]; v8[i] = kp + __shfl_xor(snd, 32); }
#pragma unroll
            for (int i = 0; i < 4; ++i) { const float snd = h2 ? v8[i] : v8[4 + i], kp = h2 ? v8[4 + i] : v8[i]; v4[i] = kp + __shfl_xor(snd, 16); }
#pragma unroll
            for (int i = 0; i < 2; ++i) { const float snd = h3 ? v4[i] : v4[2 + i], kp = h3 ? v4[2 + i] : v4[i]; v2[i] = kp + __shfl_xor(snd, 8); }
            { const float snd = h4 ? v2[0] : v2[1], kp = h4 ? v2[1] : v2[0]; v1 = kp + __shfl_xor(snd, 4); }
            v1 += __shfl_xor(v1, 2); v1 += __shfl_xor(v1, 1);
            if ((lane & 3) == 0) { const size_t o = ((size_t)(b * SEQ + t)) * 512 + g * 16 + myco;
                if (dir == 0) yscr[o] = v1;
                else { const float y = yscr[o] + v1 + dsk * bf2f(up[myco]); Z[o] = (bf16)f2bf(gelu_tanh(y)); } }
        }
    }
}
__device__ __forceinline__ void p10_final(Frame& F) {
    const float* ss = (const float*)(F.ws + WS_SS2); const f32x4* gr = (const f32x4*)F.a->in[I_GFINAL] + F.lane;
    for (int m = F.gw; m < T; m += F.NGW) {
        const float rstd = 1.0f / sqrtf(ss[m] * (1.f / 1024.f) + EPS); f32x4* xr = (f32x4*)(F.a->out + (size_t)m * D) + F.lane;
#pragma unroll
        for (int j = 0; j < 4; ++j) { const f32x4 v = xr[64 * j], gg = gr[64 * j]; xr[64 * j] = (f32x4){v.x * rstd * gg.x, v.y * rstd * gg.y, v.z * rstd * gg.z, v.w * rstd * gg.w}; }
    }
}

#ifndef MK_PER_PHASE
#define MK_PER_PHASE 0
#endif
#ifndef MK_FLAGS
#define MK_FLAGS 0
#endif
#define MK_WITH_NAIVE ((MK_FLAGS) & 1)
constexpr int N_PHASES = 11;
template <bool NAIVE_GEMM>
__device__ __forceinline__ void fwd_body(const Args& args, unsigned char* lds_raw) {
    Frame F; F.lds = (LAS unsigned char*)lds_raw; F.a = &args; F.ws = args.ws;
    F.tid = threadIdx.x; F.lane = F.tid & 63; F.wave = __builtin_amdgcn_readfirstlane(F.tid >> 6); F.G = gridDim.x;
    F.gw = blockIdx.x * NWAVES + F.wave; F.NGW = F.G * NWAVES;
    volatile LAS unsigned* MISC = (volatile LAS unsigned*)(F.lds + MISC_OFF);
    for (int u = F.tid; u < (LDS_BYTES - LDSCTL_OFF) / 4; u += NWAVES * 64) ((LAS unsigned*)(F.lds + LDSCTL_OFF))[u] = 0u;
    __syncthreads();
    unsigned char* ws = args.ws;
    const bool multi = (args.ph_hi - args.ph_lo) > 1;
    XcdBarrier bar; bar.bar = (unsigned*)(ws + WS_CTL) + CW_BAR; bar.x = 0; bar.st = nullptr;
    if (multi) bar = xcd_barrier_post((unsigned*)(ws + WS_CTL) + CW_BAR, MISC + 8);
    const int lo = args.ph_lo, hi = args.ph_hi; const int c = blockIdx.x;
#define IN(k) (lo <= (k) && (k) < hi)
#define SEAM(k) do { if (IN(k) && IN((k) + 1)) xcd_barrier(bar); } while (0)
    if (IN(0)) { p0_prologue(F); } SEAM(0);
    if (IN(1)) { p1_toeplitz(F);
        SchedP1 S{F.G, c, (const char*)(ws + WS_H), (const char*)(ws + WS_WIN), (const char*)(ws + WS_MEMN), (const char*)(ws + WS_WMKV)}; EpiP1 E{ws};
        run_gemm EpiP1, SchedP1, true>(F, S, E); } SEAM(1);
    if (IN(2)) { SchedC1 S{c, (const char*)(ws + WS_U2), (const char*)(ws + WS_WEND)}; EpiC1 E{ws};
        run_gemm EpiC1, SchedC1, false>(F, S, E);
        p2_na_simple(F); p2_mem_simple(F); } SEAM(2);
    if (IN(3)) { p3_carry(F); } SEAM(3);
    if (IN(4)) { if (args.flags & FL_NAIVE_S5) p4_s5_direct(F);
        else { SchedC3 S{c, (const char*)(ws + WS_U2), (const char*)(ws + WS_WTOEP)}; EpiC3 E{ws}; run_gemm EpiC3, SchedC3, false>(F, S, E); } } SEAM(4);
    if (IN(5)) { SchedP5 S{c, (const char*)(ws + WS_Z), (const char*)(ws + WS_WGLU)}; EpiP5 E{ws}; run_gemm EpiP5, SchedP5, false>(F, S, E); } SEAM(5);
    if (IN(6)) { SchedP6 S; pg8::tile_order(c, 64, 4, S.pm, S.pn); S.ws = (const char*)ws;
        EpiP6 E{ws, args.out + (size_t)blockIdx.x * (32 * 512 * 4), args.in[I_BGATE]};
        if (c < 256) run_gemm EpiP6, SchedP6, true>(F, S, E); } SEAM(6);
    if (IN(7)) { SchedP7 S{c, (const char*)(ws + WS_MERGED), (const char*)(ws + WS_WO), 2048, 2048, 16}; EpiRes<true> E{args.in[I_X], args.out, (bf16*)(ws + WS_X1B), (float*)(ws + WS_SS1)};
        if (c < 256) run_gemm EpiRes<true>, SchedP7, false>(F, S, E); } SEAM(7);
    if (IN(8)) { SchedP8 S{F.G, c, (const char*)(ws + WS_X1B), (const char*)(ws + WS_W13)}; EpiP8 E{ws}; run_gemm EpiP8, SchedP8, true>(F, S, E); } SEAM(8);
    if (IN(9)) { SchedP7 S{c, (const char*)(ws + WS_TT), (const char*)(ws + WS_W2), DFF * 2, DFF * 2, DFF / 64}; EpiRes<false> E{args.out, args.out, nullptr, (float*)(ws + WS_SS2)};
        if (c < 256) run_gemm EpiRes<false>, SchedP7, false>(F, S, E); } SEAM(9);
    if (IN(10)) { p10_final(F); }
#undef IN
#undef SEAM
}
#undef run_gemm
__global__ void __launch_bounds__(NWAVES * 64, 2) fwd_kernel(Args args) {
    extern __shared__ __attribute__((aligned(16))) unsigned char lds_raw[];
    fwd_body<false>(args, lds_raw);
}
#if MK_WITH_NAIVE
__global__ void __launch_bounds__(NWAVES * 64, 2) fwd_kernel_naive(Args args) {
    extern __shared__ __attribute__((aligned(16))) unsigned char lds_raw[];
    fwd_body<true>(args, lds_raw);
}
#endif

#if MK_WITH_NAIVE
#define KERNEL_FN fwd_kernel_naive
#else
#define KERNEL_FN fwd_kernel
#endif
extern "C" void kernel_launch(void* const* d_in, const int* in_sizes, int n_in, void* d_out, int out_size, void* d_ws, size_t ws_size, hipStream_t stream) {
    static int grid = 0;
    if (grid == 0) {
        if (n_in != 25 || out_size != T * D || ws_size < WS_END) { fprintf(stderr, "kernel_launch: unexpected shapes (n_in %d out %d ws %zu)\n", n_in, out_size, ws_size); grid = -1; return; }
        if (hipFuncSetAttribute((const void*)KERNEL_FN, hipFuncAttributeMaxDynamicSharedMemorySize, LDS_BYTES) != hipSuccess) { fprintf(stderr, "kernel_launch: hipFuncSetAttribute failed\n"); grid = -1; return; }
        int dev = 0, cus = 0; if (hipGetDevice(&dev) != hipSuccess || hipDeviceGetAttribute(&cus, hipDeviceAttributeMultiprocessorCount, dev) != hipSuccess) { grid = -1; return; }
        (void)hipGetLastError();
        grid = cus;
        if (grid != 256) fprintf(stderr, "kernel_launch: %d CUs (built for 256)\n", grid);
    }
    if (grid < 0) return;
    (void)hipMemsetAsync((char*)d_ws + WS_CTL, 0, CTL_ZERO_BYTES, stream);
    Args a{};
    for (int i = 0; i < 25; ++i) a.in[i] = (const float*)d_in[i];
    a.out = (float*)d_out; a.ws = (unsigned char*)d_ws; a.flags = MK_FLAGS; a.li = 0;
#if MK_PER_PHASE
    for (int ph = 0; ph < N_PHASES; ++ph) { a.ph_lo = ph; a.ph_hi = ph + 1; hipLaunchKernelGGL(KERNEL_FN, dim3(grid), dim3(NWAVES * 64), LDS_BYTES, stream, a); }
#else
    a.ph_lo = 0; a.ph_hi = N_PHASES; hipLaunchKernelGGL(KERNEL_FN, dim3(grid), dim3(NWAVES * 64), LDS_BYTES, stream, a);
#endif
}
```

```cpp
#include <hip/hip_runtime.h>
#include <cstdio>
#include <cstdint>

#define LAS __attribute__((address_space(3)))
#define GAS __attribute__((address_space(1)))
typedef unsigned short bf16;
typedef short bf16x8 __attribute__((ext_vector_type(8)));
typedef float f32x4 __attribute__((ext_vector_type(4)));
typedef float f32x2 __attribute__((ext_vector_type(2)));
typedef unsigned u32x4 __attribute__((ext_vector_type(4)));
typedef unsigned u32x2 __attribute__((ext_vector_type(2)));

constexpr int NB = 4, SEQ = 4096, T = NB * SEQ, D = 1024;
constexpr int NIN = 2560, DFF = 2816;
constexpr int CL = 32, NCH = SEQ / CL, NCR = NB * NCH, U2K = 768;
constexpr float EPS = 1e-6f;

constexpr size_t MiB = 1u << 20;
constexpr size_t WS_CTL = 0, CTL_ZERO_BYTES = 1 * MiB;
constexpr size_t WS_SS1 = 256 * 1024, WS_SS2 = 384 * 1024;
constexpr size_t WS_WIN = 2 * MiB, WS_WG = 7 * MiB, WS_WUP = 13 * MiB, WS_WO = 16 * MiB, WS_WGLU = 18 * MiB, WS_WMKV = 19 * MiB, WS_W13 = 21 * MiB, WS_W2 = 32 * MiB;
constexpr size_t WS_MEMN = 38 * MiB, WS_KVM = 40 * MiB, WS_WEND = 42 * MiB, WS_WTOEP = 50 * MiB, WS_KT = 74 * MiB;
constexpr size_t WS_MERGED = 42 * MiB;
constexpr size_t WS_H = 76 * MiB, WS_Q = 108 * MiB, WS_K = 124 * MiB, WS_V = 140 * MiB, WS_QM = 156 * MiB, WS_U2 = 172 * MiB, WS_SLOC = 196 * MiB, WS_Z = 212 * MiB, WS_YS5 = 228 * MiB;
constexpr size_t WS_G = 172 * MiB;
constexpr size_t WS_X1B = 108 * MiB;
constexpr size_t WS_TT = 140 * MiB;
constexpr size_t WS_END = 256 * MiB;
constexpr int CW_BAR = 4096;

__device__ __forceinline__ unsigned f2bf(float f) { unsigned u = __float_as_uint(f); return (u + 0x7fffu + ((u >> 16) & 1u)) >> 16; }
__device__ __forceinline__ unsigned pk2(float lo, float hi) { return f2bf(lo) | (f2bf(hi) << 16); }
__device__ __forceinline__ float bf2f(unsigned h) { return __uint_as_float(h << 16); }
__device__ __forceinline__ float bflo(unsigned w) { return __uint_as_float(w << 16); }
__device__ __forceinline__ float bfhi(unsigned w) { return __uint_as_float(w & 0xffff0000u); }
__device__ __forceinline__ unsigned cvt_pk_bf16(float lo, float hi) { unsigned r; asm volatile("v_cvt_pk_bf16_f32 %0, %1, %2" : "=v"(r) : "v"(lo), "v"(hi)); return r; }
__device__ __forceinline__ float sigmoidf_(float x) { return __builtin_amdgcn_rcpf(1.0f + __expf(-x)); }
__device__ __forceinline__ float gelu_tanh(float x) { const float a = 1.5957691216057308f * (x + 0.044715f * x * x * x); return x * sigmoidf_(a); }
__device__ __forceinline__ float wave_sum(float v) {
#pragma unroll
    for (int o = 1; o < 64; o <<= 1) v += __shfl_xor(v, o);
    return v;
}
__device__ __forceinline__ float wave_max(float v) {
#pragma unroll
    for (int o = 1; o < 64; o <<= 1) v = fmaxf(v, __shfl_xor(v, o));
    return v;
}

namespace pg8 {
constexpr int BM = 256, BK = 64, HALF = 128, HTB = HALF * BK * 2, STAGE_BYTES = 8 * HTB;
__host__ __device__ __forceinline__ int lds_byte(int r, int c) { const int st = (r >> 4) * 2 + (c >> 5), rr = r & 15, cc = c & 31, ob = rr * 64 + cc * 2; return st * 1024 + (ob ^ (((ob >> 9) & 1) << 5)); }
__host__ __device__ __forceinline__ void stage_rc(int b, int& R, int& C) { const int st = b / 1024, sb = b % 1024, swz = sb ^ (((sb >> 9) & 1) << 5); R = (st >> 1) * 16 + swz / 64; C = (st & 1) * 32 + (swz % 64) / 2; }
__host__ __device__ __forceinline__ int perm32(int rho) { const int n = rho >> 4, i = rho & 15; return 8 * (i >> 2) + 4 * n + (i & 3); }

struct Unit { const char* A; const char* B; unsigned lda, ldb; int nt, kind, pm, pn; };

__device__ __forceinline__ void tile_order(int wgid, int nM, int nN, int& pm, int& pn) {
    const int nwg = nM * nN; const int q = nwg / 8, r = nwg % 8, xcd = wgid % 8, off = wgid / 8;
    wgid = (xcd < r ? xcd * (q + 1) : r * (q + 1) + (xcd - r) * q) + off;
    const int nig = 8 * nN, gid = wgid / nig, fm = gid * 8, gsz = (nM - fm) < 8 ? (nM - fm) : 8;
    pm = fm + ((wgid % nig) % gsz); pn = (wgid % nig) / gsz;
}

template <class Epi, class Sched, bool ALIGN_EPI, bool SP2>
__device__ __forceinline__ void gemm_phase(LAS unsigned char* lds, const Sched& S, const Epi& E) {
    const int tid = threadIdx.x, wid = __builtin_amdgcn_readfirstlane(tid >> 6), lane = tid & 63, wr = wid >> 2, wc = wid & 3, fr = lane & 15, fq = lane >> 4;
    unsigned rA[2], rB[2], c2[2];
#pragma unroll
    for (int i = 0; i < 2; ++i) { int R, C; stage_rc(tid * 16 + i * 8192, R, C); rA[i] = (unsigned)R; rB[i] = (unsigned)(Epi::PERM ? ((R & ~31) + perm32(R & 31)) : R); c2[i] = (unsigned)C * 2u; }
    const size_t kstep = (size_t)(BK * 2);
    const unsigned ldsw = (unsigned)wid * 1024u;
    const int aoff = lds_byte(wr * 64 + fr, fq * 8), boff = lds_byte(wc * 32 + fr, fq * 8);
#define PG8_SA(b, h) (((b) * 2 + (h)) * HTB)
#define PG8_SB(b, h) ((4 + (b) * 2 + (h)) * HTB)
#define PG8_STAGE(bufoff, gbase, ld, RR) do { _Pragma("unroll") for (int _i = 0; _i < 2; ++_i) \
        __builtin_amdgcn_global_load_lds((const unsigned*)((const char*)(gbase) + (size_t)((RR)[_i] * (ld) + c2[_i])), (LAS unsigned*)(lds + (bufoff) + ldsw + _i * 8192), 16, 0, 0); } while (0)
#define PG8_LDA(dst, b, h) do { _Pragma("unroll") for (int m = 0; m < 4; ++m) _Pragma("unroll") for (int k = 0; k < 2; ++k) dst[m][k] = *(const LAS bf16x8*)(lds + PG8_SA(b, h) + aoff + m * 2048 + k * 1024); } while (0)
#define PG8_LDB(dst, b, h) do { _Pragma("unroll") for (int n = 0; n < 2; ++n) _Pragma("unroll") for (int k = 0; k < 2; ++k) dst[n][k] = *(const LAS bf16x8*)(lds + PG8_SB(b, h) + boff + n * 2048 + k * 1024); } while (0)
#define PG8_MMA(ai, bj, At, Bt) do { __builtin_amdgcn_s_setprio(1); _Pragma("unroll") for (int m = 0; m < 4; ++m) _Pragma("unroll") for (int n = 0; n < 2; ++n) _Pragma("unroll") for (int k = 0; k < 2; ++k) \
        acc[ai][bj][m][n] = __builtin_amdgcn_mfma_f32_16x16x32_bf16(Bt[n][k], At[m][k], acc[ai][bj][m][n], 0, 0, 0); __builtin_amdgcn_s_setprio(0); } while (0)
#define PG8_WAIT_V(n) asm volatile("s_waitcnt vmcnt(" #n ")" ::: "memory")
#define PG8_WAIT_L(n) asm volatile("s_waitcnt lgkmcnt(" #n ")" ::: "memory")
#define PG8_BAR __builtin_amdgcn_s_barrier()
#define PG8_SCHED __builtin_amdgcn_sched_barrier(0)
    Unit cur, nxt; int ui = 0;
    if (!S.next(0, cur)) return;
    f32x4 acc[2][2][4][2];
#pragma unroll
    for (int a = 0; a < 2; ++a)
#pragma unroll
        for (int b = 0; b < 2; ++b)
#pragma unroll
            for (int m = 0; m < 4; ++m)
#pragma unroll
                for (int n = 0; n < 2; ++n) acc[a][b][m][n] = (f32x4){0.f, 0.f, 0.f, 0.f};
    bf16x8 At[4][2], B0[2][2], B1[2][2];
    const char* cA = cur.A; const char* cB = cur.B; unsigned cla = cur.lda, clb = cur.ldb;
    {
        const size_t hA = (size_t)HALF * cla, hB = (size_t)HALF * clb;
        if constexpr (SP2) {
            PG8_STAGE(PG8_SB(0, 0), cB, clb, rB); PG8_STAGE(PG8_SB(0, 1), cB + hB, clb, rB); PG8_STAGE(PG8_SA(0, 0), cA, cla, rA); PG8_STAGE(PG8_SA(0, 1), cA + hA, cla, rA);
            if (wr == 1) PG8_BAR;
            PG8_WAIT_V(2); PG8_BAR;
            PG8_STAGE(PG8_SB(1, 0), cB + kstep, clb, rB); PG8_STAGE(PG8_SA(1, 0), cA + kstep, cla, rA); PG8_STAGE(PG8_SB(1, 1), cB + hB + kstep, clb, rB);
            PG8_WAIT_V(6); PG8_BAR;
        } else {
            PG8_STAGE(PG8_SB(0, 0), cB, clb, rB); PG8_STAGE(PG8_SA(0, 0), cA, cla, rA); PG8_STAGE(PG8_SB(0, 1), cB + hB, clb, rB); PG8_STAGE(PG8_SA(0, 1), cA + hA, cla, rA);
            if (wr == 1) PG8_BAR;
            PG8_WAIT_V(4); PG8_BAR;
            PG8_STAGE(PG8_SB(1, 0), cB + kstep, clb, rB); PG8_STAGE(PG8_SA(1, 0), cA + kstep, cla, rA); PG8_STAGE(PG8_SB(1, 1), cB + hB + kstep, clb, rB);
            PG8_WAIT_V(6); PG8_BAR;
        }
    }
    for (;;) {
        const bool has_next = S.next(ui + 1, nxt);
        const char* nA = has_next ? nxt.A : cA; const char* nB = has_next ? nxt.B : cB;
        const unsigned nla = has_next ? nxt.lda : cla, nlb = has_next ? nxt.ldb : clb;
        const int nt = cur.nt;
        const size_t chA = (size_t)HALF * cla;
        for (int t = 0; t < nt; t += 2) {
            const bool last = (t == nt - 2);
            const char* a1 = cA + (size_t)(t + 1) * kstep;
            const char* a2 = last ? nA : cA + (size_t)(t + 2) * kstep; const char* b2 = last ? nB : cB + (size_t)(t + 2) * kstep;
            const unsigned la2 = last ? nla : cla, lb2 = last ? nlb : clb;
            const size_t hA2 = (size_t)HALF * la2, hB2 = (size_t)HALF * lb2;
            const char* a3 = a2 + kstep; const char* b3 = b2 + kstep;
            if constexpr (SP2) {
            PG8_LDB(B0, 0, 0); PG8_LDB(B1, 0, 1); PG8_SCHED; PG8_LDA(At, 0, 0); PG8_STAGE(PG8_SA(1, 1), a1 + chA, cla, rA);
            PG8_WAIT_V(8); PG8_WAIT_L(0); PG8_BAR; PG8_MMA(0, 0, At, B0); PG8_MMA(0, 1, At, B1); PG8_BAR; PG8_SCHED;
            PG8_LDA(At, 0, 1); PG8_STAGE(PG8_SB(0, 0), b2, lb2, rB); PG8_STAGE(PG8_SB(0, 1), b2 + hB2, lb2, rB); PG8_STAGE(PG8_SA(0, 0), a2, la2, rA);
            PG8_WAIT_V(8); PG8_WAIT_L(0); PG8_BAR; PG8_MMA(1, 0, At, B0); PG8_MMA(1, 1, At, B1); PG8_BAR; PG8_SCHED;
            PG8_LDB(B0, 1, 0); PG8_LDB(B1, 1, 1); PG8_SCHED; PG8_LDA(At, 1, 0); PG8_STAGE(PG8_SA(0, 1), a2 + hA2, la2, rA);
            PG8_WAIT_V(8); PG8_WAIT_L(0); PG8_BAR; PG8_MMA(0, 0, At, B0); PG8_MMA(0, 1, At, B1); PG8_BAR; PG8_SCHED;
            PG8_LDA(At, 1, 1); PG8_STAGE(PG8_SB(1, 0), b3, lb2, rB); PG8_STAGE(PG8_SB(1, 1), b3 + hB2, lb2, rB); PG8_STAGE(PG8_SA(1, 0), a3, la2, rA);
            PG8_WAIT_V(8); PG8_WAIT_L(0); PG8_BAR; PG8_MMA(1, 0, At, B0); PG8_MMA(1, 1, At, B1); PG8_BAR; PG8_SCHED;
            } else {
            PG8_LDB(B0, 0, 0); PG8_SCHED; PG8_LDA(At, 0, 0); PG8_STAGE(PG8_SA(1, 1), a1 + chA, cla, rA);
            PG8_WAIT_L(8); PG8_BAR; PG8_WAIT_L(0); PG8_MMA(0, 0, At, B0); PG8_BAR; PG8_SCHED;
            PG8_LDB(B1, 0, 1); PG8_STAGE(PG8_SB(0, 0), b2, lb2, rB);
            PG8_BAR; PG8_WAIT_L(0); PG8_MMA(0, 1, At, B1); PG8_BAR;
            PG8_LDA(At, 0, 1); PG8_STAGE(PG8_SA(0, 0), a2, la2, rA);
            PG8_BAR; PG8_WAIT_L(0); PG8_MMA(1, 0, At, B0); PG8_BAR; PG8_SCHED;
            PG8_STAGE(PG8_SB(0, 1), b2 + hB2, lb2, rB);
            PG8_WAIT_V(6); PG8_BAR; PG8_MMA(1, 1, At, B1); PG8_BAR;
            PG8_LDB(B0, 1, 0); PG8_SCHED; PG8_LDA(At, 1, 0); PG8_STAGE(PG8_SA(0, 1), a2 + hA2, la2, rA);
            PG8_WAIT_L(8); PG8_BAR; PG8_WAIT_L(0); PG8_MMA(0, 0, At, B0); PG8_BAR; PG8_SCHED;
            PG8_LDB(B1, 1, 1); PG8_STAGE(PG8_SB(1, 0), b3, lb2, rB);
            PG8_BAR; PG8_WAIT_L(0); PG8_MMA(0, 1, At, B1); PG8_BAR;
            PG8_LDA(At, 1, 1); PG8_STAGE(PG8_SA(1, 0), a3, la2, rA);
            PG8_BAR; PG8_WAIT_L(0); PG8_MMA(1, 0, At, B0); PG8_BAR; PG8_SCHED;
            PG8_STAGE(PG8_SB(1, 1), b3 + hB2, lb2, rB);
            PG8_WAIT_V(6); PG8_BAR; PG8_MMA(1, 1, At, B1); PG8_BAR;
            }
        }
        if constexpr (ALIGN_EPI) { if (wr == 0) PG8_BAR; }
        { int fr_ = fr, fq_ = fq; asm volatile("" : "+v"(fr_), "+v"(fq_)); E(acc, cur, wr, wc, fr_, fq_); }
        if (!has_next) break;
#pragma unroll
        for (int a = 0; a < 2; ++a)
#pragma unroll
            for (int b = 0; b < 2; ++b)
#pragma unroll
                for (int m = 0; m < 4; ++m)
#pragma unroll
                    for (int n = 0; n < 2; ++n) acc[a][b][m][n] = (f32x4){0.f, 0.f, 0.f, 0.f};
        cur = nxt; cA = nA; cB = nB; cla = nla; clb = nlb; ++ui;
        if constexpr (ALIGN_EPI) { if (wr == 1) PG8_BAR; }
    }
    PG8_WAIT_V(0);
    if constexpr (!ALIGN_EPI) { if (wr == 0) PG8_BAR; }
    PG8_BAR;
#undef PG8_SA
#undef PG8_SB
#undef PG8_STAGE
#undef PG8_LDA
#undef PG8_LDB
#undef PG8_MMA
#undef PG8_WAIT_V
#undef PG8_WAIT_L
#undef PG8_BAR
#undef PG8_SCHED
}

template <class Epi, class Sched>
__device__ __forceinline__ void gemm_phase_naive(LAS unsigned char* lds, const Sched& S, const Epi& E) {
    const int tid = threadIdx.x, wid = tid >> 6, lane = tid & 63, wr = wid >> 2, wc = wid & 3, fr = lane & 15, fq = lane >> 4;
    constexpr int LDP = 72;
    LAS bf16* As = (LAS bf16*)lds; LAS bf16* Bs = As + 256 * LDP;
    Unit u;
    for (int ui = 0; S.next(ui, u); ++ui) {
        f32x4 acc[2][2][4][2];
#pragma unroll
        for (int a = 0; a < 2; ++a)
#pragma unroll
            for (int b = 0; b < 2; ++b)
#pragma unroll
                for (int m = 0; m < 4; ++m)
#pragma unroll
                    for (int n = 0; n < 2; ++n) acc[a][b][m][n] = (f32x4){0.f, 0.f, 0.f, 0.f};
#pragma unroll 1
        for (int kt = 0; kt < u.nt; ++kt) {
            __syncthreads();
            { const int row = tid >> 1, half = tid & 1;
              const u32x4* sa = (const u32x4*)(u.A + (size_t)row * u.lda + (size_t)kt * 128 + half * 64);
              const u32x4* sb = (const u32x4*)(u.B + (size_t)row * u.ldb + (size_t)kt * 128 + half * 64);
#pragma unroll
              for (int j = 0; j < 4; ++j) { *(LAS u32x4*)(As + row * LDP + half * 32 + j * 8) = sa[j]; *(LAS u32x4*)(Bs + row * LDP + half * 32 + j * 8) = sb[j]; } }
            __syncthreads();
#pragma unroll 1
            for (int kk = 0; kk < 8; ++kk) {
#pragma unroll
                for (int ai = 0; ai < 2; ++ai)
#pragma unroll
                    for (int m = 0; m < 4; ++m) {
                        float af[8];
                        { const u32x4 w = *(const LAS u32x4*)(As + (ai * 128 + wr * 64 + m * 16 + fr) * LDP + kk * 8);
                          af[0] = bflo(w.x); af[1] = bfhi(w.x); af[2] = bflo(w.y); af[3] = bfhi(w.y); af[4] = bflo(w.z); af[5] = bfhi(w.z); af[6] = bflo(w.w); af[7] = bfhi(w.w); }
#pragma unroll
                        for (int bj = 0; bj < 2; ++bj)
#pragma unroll
                            for (int n = 0; n < 2; ++n)
#pragma unroll
                                for (int e = 0; e < 4; ++e) {
                                    const int col = bj * 128 + wc * 32 + (Epi::PERM ? (8 * fq + 4 * n + e) : (16 * n + 4 * fq + e));
                                    const u32x4 w = *(const LAS u32x4*)(Bs + col * LDP + kk * 8);
                                    float s = acc[ai][bj][m][n][e];
                                    s = fmaf(af[0], bflo(w.x), s); s = fmaf(af[1], bfhi(w.x), s); s = fmaf(af[2], bflo(w.y), s); s = fmaf(af[3], bfhi(w.y), s);
                                    s = fmaf(af[4], bflo(w.z), s); s = fmaf(af[5], bfhi(w.z), s); s = fmaf(af[6], bflo(w.w), s); s = fmaf(af[7], bfhi(w.w), s);
                                    acc[ai][bj][m][n][e] = s;
                                    asm volatile("" ::: "memory");
                                }
                    }
            }
        }
        { int fr_ = fr, fq_ = fq; asm volatile("" : "+v"(fr_), "+v"(fq_)); E(acc, u, wr, wc, fr_, fq_); }
    }
    __syncthreads();
}
}
using pg8::Unit;

#define XB_TMO      128
#define XB_XCNT(j)  (256  + 64 * (j))
#define XB_XSUB(j)  (1280 + 64 * (j))
#define XB_XGEN(j)  (2304 + 64 * (j))
#define XB_TOP      3328
#define XB_TOPGEN   3392
#define XCD_BAR_WORDS 3456
#define XB_SPIN_CAP (1u << 18)
__device__ __forceinline__ unsigned xb_ld(unsigned* p)              { return __hip_atomic_load(p, __ATOMIC_RELAXED, __HIP_MEMORY_SCOPE_AGENT); }
__device__ __forceinline__ unsigned xb_add(unsigned* p, unsigned v) { return __hip_atomic_fetch_add(p, v, __ATOMIC_RELAXED, __HIP_MEMORY_SCOPE_AGENT); }
__device__ __forceinline__ unsigned xb_xcc_id() { return (unsigned)__builtin_amdgcn_s_getreg((3 << 11) | 20) & 0xFu; }
#define XB_SPIN(cond, bar) do { unsigned _sp = 0; while (cond) { __builtin_amdgcn_s_sleep(1); \
    if ((++_sp & 255u) == 0u) { if (xb_ld(&(bar)[XB_TMO])) break; if (_sp > XB_SPIN_CAP) { atomicAdd(&(bar)[XB_TMO], 1u); break; } } } } while (0)
struct XcdBarrier { unsigned* bar; unsigned x; volatile LAS unsigned* st; };
__device__ __forceinline__ XcdBarrier xcd_barrier_post(unsigned* bar, volatile LAS unsigned* st) {
    XcdBarrier b; b.bar = bar; b.x = xb_xcc_id(); b.st = st;
    if (threadIdx.x == 0) (void)xb_add(&bar[XB_XCNT(b.x)], 1u);
    return b;
}
__device__ __forceinline__ void xcd_barrier_complete(unsigned* bar, unsigned x, unsigned& nloc, unsigned& nx) {
    const unsigned G = gridDim.x * gridDim.y * gridDim.z;
    unsigned sum, cnt, mine, sp = 0u;
    for (;;) {
        sum = 0u; cnt = 0u; mine = 0u;
#pragma unroll
        for (unsigned j = 0; j < 16; ++j) { const unsigned c = xb_ld(&bar[XB_XCNT(j)]); sum += c; cnt += (c > 0u) ? 1u : 0u; mine = (j == x) ? c : mine; }
        if (sum == G) break;
        __builtin_amdgcn_s_sleep(1);
        if ((++sp & 255u) == 0u) { if (xb_ld(&bar[XB_TMO])) break; if (sp > XB_SPIN_CAP) { atomicAdd(&bar[XB_TMO], 1u); break; } }
    }
    nloc = mine > 0u ? mine : 1u; nx = cnt > 0u ? cnt : 1u;
}
__device__ __forceinline__ void xcd_barrier(const XcdBarrier& b) {
    asm volatile("s_waitcnt vmcnt(0)" ::: "memory");
    __syncthreads();
    if (threadIdx.x == 0) {
        unsigned* bar = b.bar;
        __builtin_amdgcn_s_waitcnt(0);
        unsigned nloc = b.st[0], nx = b.st[1];
        if (nloc == 0u) { xcd_barrier_complete(bar, b.x, nloc, nx); b.st[0] = nloc; b.st[1] = nx; }
        const unsigned old = xb_add(&bar[XB_XSUB(b.x)], 1u);
        const unsigned gen = old / nloc;
        if (old + 1u == (gen + 1u) * nloc) {
            __builtin_amdgcn_fence(__ATOMIC_RELEASE, "agent");
            asm volatile("s_waitcnt vmcnt(0)" ::: "memory");
            const unsigned og = xb_add(&bar[XB_TOP], 1u);
            const unsigned tg = og / nx;
            if (og + 1u == (tg + 1u) * nx) xb_add(&bar[XB_TOPGEN], 1u);
            else XB_SPIN(xb_ld(&bar[XB_TOPGEN]) == tg, bar);
            __builtin_amdgcn_fence(__ATOMIC_ACQUIRE, "agent");
            xb_add(&bar[XB_XGEN(b.x)], 1u);
            asm volatile("s_waitcnt vmcnt(0)" ::: "memory");
        } else {
            XB_SPIN(xb_ld(&bar[XB_XGEN(b.x)]) == gen, bar);
            __builtin_amdgcn_fence(__ATOMIC_ACQUIRE, "agent");
            asm volatile("s_waitcnt vmcnt(0)" ::: "memory");
        }
    }
    __syncthreads();
}

constexpr int NWAVES = 8;
constexpr int RING_BYTES = 131072, LDS_BYTES = 163840, LDSCTL_OFF = LDS_BYTES - 1024, MISC_OFF = LDSCTL_OFF + 320;
struct Args { const float* in[25]; float* out; unsigned char* ws; int ph_lo, ph_hi, flags, li; };
enum { I_X = 0, I_MEM, I_GMIX, I_GMEM, I_GFFN, I_GFINAL, I_WIN, I_WGATE, I_BGATE, I_RPB, I_WMKV, I_ARE, I_AIM, I_LOGDT, I_BRE, I_BIM, I_CRE, I_CIM, I_S5D, I_WGLU, I_WBR, I_WO, I_W1, I_W3, I_W2 };
constexpr int FL_NAIVE_GEMM = 1, FL_NAIVE_S5 = 2, FL_SIMPLE_NA = 4, FL_SIMPLE_MEM = 8;
struct Frame {
    LAS unsigned char* lds; const Args* a; unsigned char* ws;
    int tid, lane, wave, G, gw, NGW;
};

template <int MODE>
__device__ __forceinline__ void p0_transpose_item(const float* W, int N, bf16* WT, int ldt, int row_off, const float* ks, LAS float* scr, int item, int lane) {
    const int nblk = N / 32, kb = item / nblk, nb = item % nblk, k0 = 64 * kb, n0 = 32 * nb;
#pragma unroll 8
    for (int i = 0; i < 32; ++i) { const int kk = 2 * i + (lane >> 5); float v = W[(size_t)(k0 + kk) * N + n0 + (lane & 31)]; if (ks) v *= ks[k0 + kk]; scr[kk * 33 + (lane & 31)] = v; }
    asm volatile("s_waitcnt lgkmcnt(0)" ::: "memory");
    const int c = lane & 7;
#pragma unroll
    for (int j = 0; j < 4; ++j) { const int n = (lane >> 3) + 8 * j; const LAS float* s = scr + (8 * c) * 33 + n;
        u32x4 o; o.x = pk2(s[0 * 33], s[1 * 33]); o.y = pk2(s[2 * 33], s[3 * 33]); o.z = pk2(s[4 * 33], s[5 * 33]); o.w = pk2(s[6 * 33], s[7 * 33]);
        const int nn = n0 + n; const int row = MODE == 0 ? (row_off + nn) : (32 * (nn >> 4) + (nn & 15) + row_off);
        *(u32x4*)(WT + (size_t)row * ldt + k0 + 8 * c) = o; }
    asm volatile("s_waitcnt lgkmcnt(0)" ::: "memory");
}
__device__ __forceinline__ void rms_row_to_bf16(const float* xrow, const float* g, bf16* orow, int lane) {
    const f32x4* xr = (const f32x4*)xrow + lane; const f32x4* gr = (const f32x4*)g + lane;
    f32x4 v[4]; float s = 0.f;
#pragma unroll
    for (int j = 0; j < 4; ++j) { v[j] = xr[64 * j]; s += (v[j].x * v[j].x + v[j].y * v[j].y) + (v[j].z * v[j].z + v[j].w * v[j].w); }
    const float rstd = 1.0f / sqrtf(wave_sum(s) * (1.f / 1024.f) + EPS);
    u32x2* o8 = (u32x2*)orow + lane;
#pragma unroll
    for (int j = 0; j < 4; ++j) { const f32x4 gg = gr[64 * j]; u32x2 w; w.x = pk2(v[j].x * rstd * gg.x, v[j].y * rstd * gg.y); w.y = pk2(v[j].z * rstd * gg.z, v[j].w * rstd * gg.w); o8[64 * j] = w; }
}
__device__ __forceinline__ f32x2 s5_cpow(float lr, float li, float dtv, int k) {
    const float mag = __expf((float)k * lr * dtv);
    double rev = (double)k * (double)li * (double)dtv * 0.15915494309189535;
    rev -= rint(rev);
    const float fr = (float)rev;
    return (f32x2){mag * __builtin_amdgcn_cosf(fr), mag * __builtin_amdgcn_sinf(fr)};
}
__device__ __forceinline__ f32x2 cmul(f32x2 a, f32x2 b) { return (f32x2){a.x * b.x - a.y * b.y, a.x * b.y + a.y * b.x}; }
__device__ __forceinline__ f32x2 s5_q(float lr, float li, float dtv) {
    const f32x2 lb = s5_cpow(lr, li, dtv, 1);
    const float nx = lb.x - 1.f, ny = lb.y, inv = 1.f / (lr * lr + li * li);
    return (f32x2){(nx * lr + ny * li) * inv, (ny * lr - nx * li) * inv};
}

__device__ __forceinline__ void p0_prologue(Frame& F) {
    const Args& A = *F.a; unsigned char* ws = F.ws; const int lane = F.lane;
    LAS float* scr = (LAS float*)(F.lds + F.wave * 16384);
    constexpr int I_IN = 16 * (NIN / 32), I_G = 16 * (3072 / 32), I_UP = 8 * 32, I_O = 16 * 32, I_GLU = 8 * 16, I_MKV = 16 * 32, I_F = 16 * (DFF / 32), I_2 = (DFF / 64) * 32;
    constexpr int NITEMS = I_IN + I_G + 3 * I_UP + I_O + I_GLU + I_MKV + 2 * I_F + I_2;
    for (int it = F.gw; it < NITEMS; it += F.NGW) {
        int r = it;
        if (r < I_IN) { p0_transpose_item<0>(A.in[I_WIN], NIN, (bf16*)(ws + WS_WIN), 1024, 0, nullptr, scr, r, lane); continue; } r -= I_IN;
        if (r < I_G) { p0_transpose_item<0>(A.in[I_WGATE], 3072, (bf16*)(ws + WS_WG), 1024, 0, nullptr, scr, r, lane); continue; } r -= I_G;
        if (r < 3 * I_UP) { const int b = r / I_UP; p0_transpose_item<0>(A.in[I_WBR] + (size_t)b * 512 * 1024, 1024, (bf16*)(ws + WS_WUP), 512, b * 1024, nullptr, scr, r % I_UP, lane); continue; } r -= 3 * I_UP;
        if (r < I_O) { p0_transpose_item<0>(A.in[I_WO], 1024, (bf16*)(ws + WS_WO), 1024, 0, nullptr, scr, r, lane); continue; } r -= I_O;
        if (r < I_GLU) { p0_transpose_item<0>(A.in[I_WGLU], 512, (bf16*)(ws + WS_WGLU), 512, 0, nullptr, scr, r, lane); continue; } r -= I_GLU;
        if (r < I_MKV) { p0_transpose_item<0>(A.in[I_WMKV], 1024, (bf16*)(ws + WS_WMKV), 1024, 0, nullptr, scr, r, lane); continue; } r -= I_MKV;
        if (r < I_F) { p0_transpose_item<1>(A.in[I_W1], DFF, (bf16*)(ws + WS_W13), 1024, 0, A.in[I_GFFN], scr, r, lane); continue; } r -= I_F;
        if (r < I_F) { p0_transpose_item<1>(A.in[I_W3], DFF, (bf16*)(ws + WS_W13), 1024, 16, A.in[I_GFFN], scr, r, lane); continue; } r -= I_F;
        p0_transpose_item<0>(A.in[I_W2], 1024, (bf16*)(ws + WS_W2), DFF, 0, nullptr, scr, r, lane);
    }
    for (int m = F.gw; m < T + 1024; m += F.NGW) {
        if (m < T) rms_row_to_bf16(A.in[I_X] + (size_t)m * D, A.in[I_GMIX], (bf16*)(ws + WS_H) + (size_t)m * D, lane);
        else rms_row_to_bf16(A.in[I_MEM] + (size_t)(m - T) * D, A.in[I_GMEM], (bf16*)(ws + WS_MEMN) + (size_t)(m - T) * D, lane);
    }
    const float *a_re = A.in[I_ARE], *a_im = A.in[I_AIM], *log_dt = A.in[I_LOGDT], *b_re = A.in[I_BRE], *b_im = A.in[I_BIM], *c_re = A.in[I_CRE], *c_im = A.in[I_CIM];
    for (int it = F.gw; it < 32 * 256; it += F.NGW) {
        const int g = it >> 8, n = it & 255, dir = n >> 7, comp = (n >> 6) & 1, p = n & 63;
        const int pi = (dir * 32 + g) * 64 + p; const float lr = a_re[pi], li = a_im[pi], dtv = expf(log_dt[dir * 32 + g]);
        const int j = lane >> 1, ci0 = (lane & 1) * 8;
        const f32x2 coef = cmul(s5_cpow(lr, li, dtv, dir == 0 ? (CL - 1 - j) : j), s5_q(lr, li, dtv));
        float o[8];
#pragma unroll
        for (int i = 0; i < 8; ++i) { const f32x2 bb = (f32x2){b_re[(size_t)pi * 16 + ci0 + i], b_im[(size_t)pi * 16 + ci0 + i]}; const f32x2 v = cmul(coef, bb); o[i] = comp ? v.y : v.x; }
        u32x4 w; w.x = pk2(o[0], o[1]); w.y = pk2(o[2], o[3]); w.z = pk2(o[4], o[5]); w.w = pk2(o[6], o[7]);
        *(u32x4*)((bf16*)(ws + WS_WEND) + ((size_t)(g * 256 + n)) * 512 + lane * 8) = w;
    }
    for (int it = F.gw; it < 32 * 512; it += F.NGW) {
        const int g = it >> 9, n = it & 511, t = n >> 4, co = n & 15;
        const int dir = lane >> 5, comp = (lane >> 4) & 1, p0 = (lane & 15) * 4;
        const float dtv = expf(log_dt[dir * 32 + g]);
        float o[4];
#pragma unroll
        for (int i = 0; i < 4; ++i) { const int p = p0 + i, pi = (dir * 32 + g) * 64 + p;
            const f32x2 w = s5_cpow(a_re[pi], a_im[pi], dtv, dir == 0 ? (t + 1) : (CL - t));
            const int cidx = ((dir * 32 + g) * 16 + co) * 64 + p; const f32x2 v = cmul((f32x2){c_re[cidx], c_im[cidx]}, w); o[i] = comp ? -v.y : v.x; }
        u32x2 w2; w2.x = pk2(o[0], o[1]); w2.y = pk2(o[2], o[3]);
        *(u32x2*)((bf16*)(ws + WS_WTOEP) + ((size_t)(g * 512 + n)) * U2K + 512 + lane * 4) = w2;
    }
    {
        LAS f32x2* vs = (LAS f32x2*)scr;
        for (int it = F.gw; it < 32 * 2 * 32; it += F.NGW) {
            const int g = it >> 6, dir = (it >> 5) & 1, lag = it & 31, p = lane;
            const int pi = (dir * 32 + g) * 64 + p; const float lr = a_re[pi], li = a_im[pi], dtv = expf(log_dt[dir * 32 + g]);
            const f32x2 coef = cmul(s5_cpow(lr, li, dtv, lag), s5_q(lr, li, dtv));
#pragma unroll
            for (int ci = 0; ci < 16; ++ci) vs[p * 16 + ci] = cmul(coef, (f32x2){b_re[(size_t)pi * 16 + ci], b_im[(size_t)pi * 16 + ci]});
            asm volatile("s_waitcnt lgkmcnt(0)" ::: "memory");
            const int co = lane >> 2, cib = (lane & 3) * 4; float s[4] = {0.f, 0.f, 0.f, 0.f};
            const float* cr = c_re + ((size_t)((dir * 32 + g) * 16 + co)) * 64; const float* cim = c_im + ((size_t)((dir * 32 + g) * 16 + co)) * 64;
            for (int pp = 0; pp < 64; ++pp) { const float x = cr[pp], y = cim[pp];
#pragma unroll
                for (int i = 0; i < 4; ++i) { const f32x2 v = vs[pp * 16 + cib + i]; s[i] += x * v.x - y * v.y; } }
            *(f32x4*)((float*)(ws + WS_KT) + (size_t)it * 256 + lane * 4) = (f32x4){s[0], s[1], s[2], s[3]};
            asm volatile("s_waitcnt lgkmcnt(0)" ::: "memory");
        }
    }
}
__device__ __forceinline__ void p1_toeplitz(Frame& F) {
    const Args& A = *F.a; unsigned char* ws = F.ws; const int lane = F.lane;
    const float* KT = (const float*)(ws + WS_KT); const float* dsk = A.in[I_S5D];
    for (int it = F.gw; it < 32 * 512; it += F.NGW) {
        const int g = it >> 9, n = it & 511, t = n >> 4, co = n & 15, j = lane >> 1, ci0 = (lane & 1) * 8;
        float o[8];
        if (t != j) { const int dir = t > j ? 0 : 1, lag = t > j ? t - j : j - t; const f32x4* s = (const f32x4*)(KT + ((size_t)((g * 2 + dir) * 32 + lag)) * 256 + co * 16 + ci0);
            const f32x4 a = s[0], b = s[1]; o[0] = a.x; o[1] = a.y; o[2] = a.z; o[3] = a.w; o[4] = b.x; o[5] = b.y; o[6] = b.z; o[7] = b.w; }
        else { const f32x4* s0 = (const f32x4*)(KT + ((size_t)((g * 2 + 0) * 32)) * 256 + co * 16 + ci0); const f32x4* s1 = (const f32x4*)(KT + ((size_t)((g * 2 + 1) * 32)) * 256 + co * 16 + ci0);
            const f32x4 a = s0[0] + s1[0], b = s0[1] + s1[1]; o[0] = a.x; o[1] = a.y; o[2] = a.z; o[3] = a.w; o[4] = b.x; o[5] = b.y; o[6] = b.z; o[7] = b.w;
            const float dv = dsk[g * 16 + co];
#pragma unroll
            for (int i = 0; i < 8; ++i) if (ci0 + i == co) o[i] += dv; }
        u32x4 w; w.x = pk2(o[0], o[1]); w.y = pk2(o[2], o[3]); w.z = pk2(o[4], o[5]); w.w = pk2(o[6], o[7]);
        *(u32x4*)((bf16*)(ws + WS_WTOEP) + ((size_t)(g * 512 + n)) * U2K + lane * 8) = w;
    }
}

#define EPI_FOR  _Pragma("unroll") for (int ai = 0; ai < 2; ++ai) _Pragma("unroll") for (int m = 0; m < 4; ++m) _Pragma("unroll") for (int bj = 0; bj < 2; ++bj) _Pragma("unroll") for (int n = 0; n < 2; ++n)
#define EPI_ROW  (u.pm * 256 + ai * 128 + wr * 64 + m * 16 + fr)
#define EPI_COL  (u.pn * 256 + bj * 128 + wc * 32 + n * 16 + fq * 4)
__device__ __forceinline__ u32x2 pack4(f32x4 v) { u32x2 w; w.x = cvt_pk_bf16(v.x, v.y); w.y = cvt_pk_bf16(v.z, v.w); return w; }

struct SchedP1 { int G, c; const char *H, *WIN, *MEMN, *WMKV;
    __device__ __forceinline__ bool next(int i, Unit& u) const {
        const int L = i * G + c; if (L >= 656) return false;
        if (L < 640) { int pm, pn; pg8::tile_order(L, 64, 10, pm, pn); u.A = H + (size_t)pm * 256 * 2048; u.B = WIN + (size_t)pn * 256 * 2048; u.kind = pn >> 1; u.pm = pm; u.pn = pn; }
        else { const int l = L - 640, pm = l >> 2, pn = l & 3; u.A = MEMN + (size_t)pm * 256 * 2048; u.B = WMKV + (size_t)pn * 256 * 2048; u.kind = 5; u.pm = pm; u.pn = pn; }
        u.lda = 2048; u.ldb = 2048; u.nt = 16; return true; } };
struct EpiP1 { static constexpr bool PERM = false; unsigned char* ws;
    __device__ __forceinline__ void operator()(const f32x4 (&acc)[2][2][4][2], const Unit& u, int wr, int wc, int fr, int fq) const {
        EPI_FOR { const int row = EPI_ROW, col = EPI_COL; const u32x2 w = pack4(acc[ai][bj][m][n]); bf16* dst;
            if (u.kind <= 2) dst = (bf16*)(ws + WS_Q + (size_t)u.kind * (WS_K - WS_Q)) + (size_t)row * 512 + (col - u.kind * 512);
            else if (u.kind == 3) { const int cl = col - 1536, g = cl >> 4, ci = cl & 15, b = row >> 12, s = row & 4095, c = s >> 5, t = s & 31;
                dst = (bf16*)(ws + WS_U2) + ((size_t)(g * NCR + b * NCH + c)) * U2K + t * 16 + ci; }
            else if (u.kind == 4) dst = (bf16*)(ws + WS_QM) + (size_t)row * 512 + (col - 2048);
            else dst = (bf16*)(ws + WS_KVM) + (size_t)row * 1024 + col;
            *(u32x2*)dst = w; }
    } };
struct SchedC1 { int c; const char *U2, *WEND;
    __device__ __forceinline__ bool next(int i, Unit& u) const {
        if (i > 0 || c >= 64) return false; const int g = c >> 1, pm = c & 1;
        u.A = U2 + ((size_t)(g * NCR + pm * 256)) * U2K * 2; u.B = WEND + (size_t)g * 256 * 512 * 2; u.lda = U2K * 2; u.ldb = 1024; u.nt = 8; u.kind = g; u.pm = pm; u.pn = 0; return true; } };
struct EpiC1 { static constexpr bool PERM = false; unsigned char* ws;
    __device__ __forceinline__ void operator()(const f32x4 (&acc)[2][2][4][2], const Unit& u, int wr, int wc, int fr, int fq) const {
        EPI_FOR { const int row = EPI_ROW, col = EPI_COL; *(f32x4*)((float*)(ws + WS_SLOC) + ((size_t)(u.kind * NCR + row)) * 256 + col) = acc[ai][bj][m][n]; }
    } };
struct SchedC3 { int c; const char *U2, *WT;
    __device__ __forceinline__ bool next(int i, Unit& u) const {
        if (i > 0 || c >= 128) return false; const int g = c >> 2, pm = (c >> 1) & 1, pn = c & 1;
        u.A = U2 + ((size_t)(g * NCR + pm * 256)) * U2K * 2; u.B = WT + ((size_t)(g * 512 + pn * 256)) * U2K * 2; u.lda = U2K * 2; u.ldb = U2K * 2; u.nt = 12; u.kind = g; u.pm = pm; u.pn = pn; return true; } };
struct EpiC3 { static constexpr bool PERM = false; unsigned char* ws;
    __device__ __forceinline__ void operator()(const f32x4 (&acc)[2][2][4][2], const Unit& u, int wr, int wc, int fr, int fq) const {
        EPI_FOR { const int row = EPI_ROW, col = EPI_COL; const int b = row >> 7, c = row & 127, t = col >> 4, co = col & 15;
            f32x4 v = acc[ai][bj][m][n]; v.x = gelu_tanh(v.x); v.y = gelu_tanh(v.y); v.z = gelu_tanh(v.z); v.w = gelu_tanh(v.w);
            *(u32x2*)((bf16*)(ws + WS_Z) + ((size_t)(b * SEQ + c * CL + t)) * 512 + u.kind * 16 + co) = pack4(v); }
    } };
struct SchedP5 { int c; const char *Z, *WGLU;
    __device__ __forceinline__ bool next(int i, Unit& u) const {
        if (i > 0 || c >= 128) return false; int pm, pn; pg8::tile_order(c, 64, 2, pm, pn);
        u.A = Z + (size_t)pm * 256 * 1024; u.B = WGLU + (size_t)pn * 256 * 1024; u.lda = 1024; u.ldb = 1024; u.nt = 8; u.kind = 0; u.pm = pm; u.pn = pn; return true; } };
struct EpiP5 { static constexpr bool PERM = false; unsigned char* ws;
    __device__ __forceinline__ void operator()(const f32x4 (&acc)[2][2][4][2], const Unit& u, int wr, int wc, int fr, int fq) const {
        EPI_FOR { const int row = EPI_ROW, col = EPI_COL; const u32x2 zz = *(const u32x2*)((const bf16*)(ws + WS_Z) + (size_t)row * 512 + col);
            f32x4 v = acc[ai][bj][m][n]; v.x = bflo(zz.x) * sigmoidf_(v.x); v.y = bfhi(zz.x) * sigmoidf_(v.y); v.z = bflo(zz.y) * sigmoidf_(v.z); v.w = bfhi(zz.y) * sigmoidf_(v.w);
            *(u32x2*)((bf16*)(ws + WS_YS5) + (size_t)row * 512 + col) = pack4(v); }
    } };
struct SchedP6 { int pm, pn; const char* ws;
    __device__ __forceinline__ bool next(int i, Unit& u) const {
        if (i >= 6) return false; const int b = i >> 1;
        if ((i & 1) == 0) { u.A = ws + WS_H + (size_t)pm * 256 * 2048; u.B = ws + WS_WG + ((size_t)(b * 1024 + pn * 256)) * 2048; u.lda = 2048; u.ldb = 2048; u.nt = 16; }
        else { const size_t yo = b == 0 ? WS_Q : (b == 1 ? WS_YS5 : WS_QM); u.A = ws + yo + (size_t)pm * 256 * 1024; u.B = ws + WS_WUP + ((size_t)(b * 1024 + pn * 256)) * 1024; u.lda = 1024; u.ldb = 1024; u.nt = 8; }
        u.kind = i; u.pm = pm; u.pn = pn; return true; } };
struct EpiP6 { static constexpr bool PERM = false; unsigned char* ws; float* part; const float* bgate;
    __device__ __forceinline__ void operator()(const f32x4 (&acc)[2][2][4][2], const Unit& u, int wr, int wc, int fr, int fq) const {
        const int b = u.kind >> 1; int tid = threadIdx.x; asm volatile("" : "+v"(tid));
        u32x2* gs = (u32x2*)(ws + WS_G) + (size_t)blockIdx.x * (32 * 512) + tid; f32x4* ps = (f32x4*)part + tid;
        if ((u.kind & 1) == 0) {
            EPI_FOR { const int col = EPI_COL; const f32x4 bv = *(const f32x4*)(bgate + b * 1024 + col); f32x4 v = acc[ai][bj][m][n] + bv;
                v.x = sigmoidf_(v.x); v.y = sigmoidf_(v.y); v.z = sigmoidf_(v.z); v.w = sigmoidf_(v.w);
                gs[(((ai * 2 + bj) * 4 + m) * 2 + n) * 512] = pack4(v); }
        } else {
#pragma unroll
            for (int ai = 0; ai < 2; ++ai)
#pragma unroll
                for (int m = 0; m < 4; ++m) {
#pragma unroll
                    for (int bj = 0; bj < 2; ++bj)
#pragma unroll
                        for (int n = 0; n < 2; ++n) { const int slot = ((ai * 2 + bj) * 4 + m) * 2 + n; const u32x2 gg = gs[slot * 512];
                            f32x4 v = acc[ai][bj][m][n]; v.x *= bflo(gg.x); v.y *= bfhi(gg.x); v.z *= bflo(gg.y); v.w *= bfhi(gg.y);
                            if (b > 0) v += ps[slot * 512];
                            if (b < 2) ps[slot * 512] = v;
                            else { const int row = EPI_ROW, col = EPI_COL; *(u32x2*)((bf16*)(ws + WS_MERGED) + (size_t)row * 1024 + col) = pack4(v); } }
                    asm volatile("" ::: "memory"); }
        }
    } };
struct SchedP7 { int c; const char *A0, *B0; unsigned lda, ldb; int nt;
    __device__ __forceinline__ bool next(int i, Unit& u) const {
        if (i > 0) return false; int pm, pn; pg8::tile_order(c, 64, 4, pm, pn);
        u.A = A0 + (size_t)pm * 256 * lda; u.B = B0 + (size_t)pn * 256 * ldb; u.lda = lda; u.ldb = ldb; u.nt = nt; u.kind = 0; u.pm = pm; u.pn = pn; return true; } };
template <bool WRITE_BF>
struct EpiRes { static constexpr bool PERM = false; const float* base; float* out; bf16* xb; float* ss;
    __device__ __forceinline__ void operator()(const f32x4 (&acc)[2][2][4][2], const Unit& u, int wr, int wc, int fr, int fq) const {
#pragma unroll
        for (int ai = 0; ai < 2; ++ai)
#pragma unroll
            for (int m = 0; m < 4; ++m) { const int row = EPI_ROW; float s = 0.f;
#pragma unroll
                for (int bj = 0; bj < 2; ++bj)
#pragma unroll
                    for (int n = 0; n < 2; ++n) { const int col = EPI_COL; const size_t off = (size_t)row * 1024 + col;
                        const f32x4 v = *(const f32x4*)(base + off) + acc[ai][bj][m][n]; *(f32x4*)(out + off) = v; s += (v.x * v.x + v.y * v.y) + (v.z * v.z + v.w * v.w);
                        if (WRITE_BF) *(u32x2*)(xb + off) = pack4(v); }
                s += __shfl_xor(s, 16); s += __shfl_xor(s, 32);
                if (fq == 0) unsafeAtomicAdd(ss + row, s); }
    } };
struct SchedP8 { int G, c; const char *X1B, *W13;
    __device__ __forceinline__ bool next(int i, Unit& u) const {
        const int L = i * G + c; if (L >= 64 * 22) return false; int pm, pn; pg8::tile_order(L, 64, 22, pm, pn);
        u.A = X1B + (size_t)pm * 256 * 2048; u.B = W13 + (size_t)pn * 256 * 2048; u.lda = 2048; u.ldb = 2048; u.nt = 16; u.kind = 0; u.pm = pm; u.pn = pn; return true; } };
struct EpiP8 { static constexpr bool PERM = false; unsigned char* ws;
    __device__ __forceinline__ void operator()(const f32x4 (&acc)[2][2][4][2], const Unit& u, int wr, int wc, int fr, int fq) const {
        const float* ss = (const float*)(ws + WS_SS1);
#pragma unroll
        for (int ai = 0; ai < 2; ++ai)
#pragma unroll
            for (int m = 0; m < 4; ++m) { const int row = EPI_ROW; const float rstd = 1.0f / sqrtf(ss[row] * (1.f / 1024.f) + EPS);
#pragma unroll
                for (int bj = 0; bj < 2; ++bj) { const f32x4 a = acc[ai][bj][m][0] * rstd, b = acc[ai][bj][m][1] * rstd; f32x4 v;
                    v.x = a.x * sigmoidf_(a.x) * b.x; v.y = a.y * sigmoidf_(a.y) * b.y; v.z = a.z * sigmoidf_(a.z) * b.z; v.w = a.w * sigmoidf_(a.w) * b.w;
                    *(u32x2*)((bf16*)(ws + WS_TT) + (size_t)row * DFF + u.pn * 128 + bj * 64 + wc * 16 + fq * 4) = pack4(v); } }
    } };

template <bool NAIVE, class Epi, class Sched, bool MULTI>
__device__ __forceinline__ void run_gemm_(Frame& F, const Sched& S, const Epi& E) {
    if constexpr (NAIVE) pg8::gemm_phase_naive<Epi, Sched>(F.lds, S, E);
    else pg8::gemm_phase<Epi, Sched, MULTI, true>(F.lds, S, E);
}
#define run_gemm run_gemm_<NAIVE_GEMM,

__device__ __forceinline__ void p2_na_simple(Frame& F) {
    unsigned char* ws = F.ws; const int lane = F.lane; const float* rpb = F.a->in[I_RPB];
    const bf16* Q = (const bf16*)(ws + WS_Q); const bf16* K = (const bf16*)(ws + WS_K); const bf16* V = (const bf16*)(ws + WS_V); bf16* Y = (bf16*)(ws + WS_Q);
    LAS float* pl = (LAS float*)(F.lds + F.wave * 1024);
    for (int it = F.gw; it < T * 8; it += F.NGW) {
        const int token = it >> 3, h = it & 7, b = token >> 12, s = token & 4095, r = s >> 6, c = s & 63;
        const int rs = min(max(r - 4, 0), 56), cs = min(max(c - 8, 0), 48);
        const u32x4* qp = (const u32x4*)(Q + (size_t)token * 512 + h * 64);
        float sc[2];
#pragma unroll
        for (int e = 0; e < 2; ++e) { const int kk = lane * 2 + e, i = kk >> 4, w = kk & 15, kt = (b << 12) + ((rs + i) << 6) + cs + w;
            const u32x4* kp = (const u32x4*)(K + (size_t)kt * 512 + h * 64); float d = 0.f;
#pragma unroll
            for (int j = 0; j < 8; ++j) { const u32x4 a = qp[j], k4 = kp[j];
                d += bflo(a.x) * bflo(k4.x) + bfhi(a.x) * bfhi(k4.x) + bflo(a.y) * bflo(k4.y) + bfhi(a.y) * bfhi(k4.y) + bflo(a.z) * bflo(k4.z) + bfhi(a.z) * bfhi(k4.z) + bflo(a.w) * bflo(k4.w) + bfhi(a.w) * bfhi(k4.w); }
            const int rr = rs + i - r + 7, rc = min(max(cs + w - c + 15, 0), 30);
            sc[e] = d * 0.125f + rpb[(h * 15 + rr) * 31 + rc]; }
        const float mx = wave_max(fmaxf(sc[0], sc[1])); const float p0 = __expf(sc[0] - mx), p1 = __expf(sc[1] - mx); const float l = wave_sum(p0 + p1);
        pl[lane * 2] = p0; pl[lane * 2 + 1] = p1;
        asm volatile("s_waitcnt lgkmcnt(0)" ::: "memory");
        float o = 0.f;
        for (int kk = 0; kk < 128; ++kk) { const int i = kk >> 4, w = kk & 15, kt = (b << 12) + ((rs + i) << 6) + cs + w; o += pl[kk] * bf2f(V[(size_t)kt * 512 + h * 64 + lane]); }
        Y[(size_t)token * 512 + h * 64 + lane] = (bf16)f2bf(o / l);
        asm volatile("s_waitcnt lgkmcnt(0)" ::: "memory");
    }
}
__device__ __forceinline__ void p2_mem_simple(Frame& F) {
    unsigned char* ws = F.ws; const int lane = F.lane;
    const bf16* QM = (const bf16*)(ws + WS_QM); const bf16* KVM = (const bf16*)(ws + WS_KVM); bf16* Y = (bf16*)(ws + WS_QM);
    LAS float* pl = (LAS float*)(F.lds + 8192 + F.wave * 1024);
    for (int it = F.gw; it < T * 4; it += F.NGW) {
        const int token = it >> 2, h = it & 3, b = token >> 12;
        const u32x4* qp = (const u32x4*)(QM + (size_t)token * 512 + h * 128);
        float sc[4];
#pragma unroll
        for (int e = 0; e < 4; ++e) { const int mm = lane * 4 + e; const u32x4* kp = (const u32x4*)(KVM + ((size_t)(b * 256 + mm)) * 1024 + h * 128); float d = 0.f;
#pragma unroll
            for (int j = 0; j < 16; ++j) { const u32x4 a = qp[j], k4 = kp[j];
                d += bflo(a.x) * bflo(k4.x) + bfhi(a.x) * bfhi(k4.x) + bflo(a.y) * bflo(k4.y) + bfhi(a.y) * bfhi(k4.y) + bflo(a.z) * bflo(k4.z) + bfhi(a.z) * bfhi(k4.z) + bflo(a.w) * bflo(k4.w) + bfhi(a.w) * bfhi(k4.w); }
            sc[e] = d * 0.08838834764831845f; }
        const float mx = wave_max(fmaxf(fmaxf(sc[0], sc[1]), fmaxf(sc[2], sc[3])));
        float p[4]; float ls = 0.f;
#pragma unroll
        for (int e = 0; e < 4; ++e) { p[e] = __expf(sc[e] - mx); ls += p[e]; pl[lane * 4 + e] = p[e]; }
        const float l = wave_sum(ls);
        asm volatile("s_waitcnt lgkmcnt(0)" ::: "memory");
        float o0 = 0.f, o1 = 0.f;
        for (int mm = 0; mm < 256; ++mm) { const unsigned vv = *(const unsigned*)(KVM + ((size_t)(b * 256 + mm)) * 1024 + 512 + h * 128 + lane * 2); const float pp = pl[mm]; o0 += pp * bflo(vv); o1 += pp * bfhi(vv); }
        *(unsigned*)(Y + (size_t)token * 512 + h * 128 + lane * 2) = pk2(o0 / l, o1 / l);
        asm volatile("s_waitcnt lgkmcnt(0)" ::: "memory");
    }
}

typedef short s16x4 __attribute__((ext_vector_type(4)));
__device__ __forceinline__ s16x4 lds_tr16(const LAS unsigned char* p) { return __builtin_amdgcn_ds_read_tr16_b64_v4i16((LAS s16x4*)p); }
__device__ __forceinline__ bf16x8 cat8(s16x4 lo, s16x4 hi) { return __builtin_shufflevector(lo, hi, 0, 1, 2, 3, 4, 5, 6, 7); }
__device__ __forceinline__ bf16x8 pack8(f32x4 a, f32x4 b) { u32x4 w; w.x = cvt_pk_bf16(a.x, a.y); w.y = cvt_pk_bf16(a.z, a.w); w.z = cvt_pk_bf16(b.x, b.y); w.w = cvt_pk_bf16(b.z, b.w); return __builtin_bit_cast(bf16x8, w); }
__device__ __forceinline__ void p2_na_mfma(Frame& F) {
    unsigned char* ws = F.ws; const int tid = F.tid, lane = F.lane, w = F.wave, g = lane >> 4, i16 = lane & 15;
    const bf16* Q = (const bf16*)(ws + WS_Q); const bf16* K = (const bf16*)(ws + WS_K); const bf16* V = (const bf16*)(ws + WS_V); bf16* Y = (bf16*)(ws + WS_Q);
    const float* rpb = F.a->in[I_RPB];
    LAS unsigned char* Ks = F.lds; LAS unsigned char* Vs = F.lds + 73728; LAS float* Rp = (LAS float*)(F.lds + 147456);
    for (int unit = blockIdx.x; unit < 1024; unit += F.G) {
        const int rp = unit & 31, h = (unit >> 5) & 7, b = unit >> 8;
        const int r0 = rp * 2, rs0 = min(max(r0 - 4, 0), 56);
        __syncthreads();
        for (int x = tid; x < 465; x += NWAVES * 64) Rp[x] = rpb[h * 465 + x];
#pragma unroll
        for (int j = 0; j < 9; ++j) { const int grow = rs0 + j;
            if (grow < 64) { const int row = j * 64 + (tid >> 3), ch = tid & 7; const size_t tok = (size_t)b * SEQ + grow * 64 + (tid >> 3);
                const u32x4 kv = *(const u32x4*)(K + tok * 512 + h * 64 + ch * 8); const u32x4 vv = *(const u32x4*)(V + tok * 512 + h * 64 + ch * 8);
                *(LAS u32x4*)(Ks + row * 128 + ((ch ^ ((row >> 1) & 7)) << 4)) = kv; *(LAS u32x4*)(Vs + row * 128 + ((ch ^ (2 * ((row >> 1) & 3))) << 4)) = vv; } }
        __syncthreads();
        const int rr = r0 + (w >> 2), a = w & 3, rsw = min(max(rr - 4, 0), 56), brow0 = rsw - rs0;
        const int cw0 = a == 0 ? 0 : (a == 1 ? 8 : (a == 2 ? 24 : 32));
        const int c = 16 * a + i16, cs = min(max(c - 8, 0), 48);
        const size_t qtok = (size_t)b * SEQ + rr * 64 + c;
        bf16x8 qf[2];
#pragma unroll
        for (int ks = 0; ks < 2; ++ks) { const u32x4 q4 = *(const u32x4*)(Q + qtok * 512 + h * 64 + 32 * ks + 8 * g);
            u32x4 o; o.x = cvt_pk_bf16(bflo(q4.x) * 0.125f, bfhi(q4.x) * 0.125f); o.y = cvt_pk_bf16(bflo(q4.y) * 0.125f, bfhi(q4.y) * 0.125f);
            o.z = cvt_pk_bf16(bflo(q4.z) * 0.125f, bfhi(q4.z) * 0.125f); o.w = cvt_pk_bf16(bflo(q4.w) * 0.125f, bfhi(q4.w) * 0.125f); qf[ks] = __builtin_bit_cast(bf16x8, o); }
        f32x4 s[8][2];
#pragma unroll
        for (int i = 0; i < 8; ++i)
#pragma unroll
            for (int t = 0; t < 2; ++t) { f32x4 ci;
#pragma unroll
                for (int reg = 0; reg < 4; ++reg) { const int ck = cw0 + 16 * t + 4 * g + reg; const bool valid = (ck >= cs) && (ck < cs + 16);
                    const int idx = (rsw + i - rr + 7) * 31 + min(max(ck - c + 15, 0), 30); const float bv = Rp[idx]; ci[reg] = valid ? bv : -1e30f; }
                const int krow = (brow0 + i) * 64 + cw0 + 16 * t + i16; const LAS unsigned char* kb = Ks + krow * 128; const int swz = (krow >> 1) & 7;
                const bf16x8 k0 = *(const LAS bf16x8*)(kb + ((g ^ swz) << 4)), k1 = *(const LAS bf16x8*)(kb + (((4 + g) ^ swz) << 4));
                ci = __builtin_amdgcn_mfma_f32_16x16x32_bf16(k0, qf[0], ci, 0, 0, 0); s[i][t] = __builtin_amdgcn_mfma_f32_16x16x32_bf16(k1, qf[1], ci, 0, 0, 0); }
        float m = -3e38f;
#pragma unroll
        for (int i = 0; i < 8; ++i)
#pragma unroll
            for (int t = 0; t < 2; ++t) m = fmaxf(fmaxf(fmaxf(s[i][t].x, s[i][t].y), fmaxf(s[i][t].z, s[i][t].w)), m);
        m = fmaxf(m, __shfl_xor(m, 16)); m = fmaxf(m, __shfl_xor(m, 32));
        float lsum = 0.f; const float mm = m * 1.4426950408889634f;
#pragma unroll
        for (int i = 0; i < 8; ++i)
#pragma unroll
            for (int t = 0; t < 2; ++t) { f32x4 p; p.x = __builtin_amdgcn_exp2f(s[i][t].x * 1.4426950408889634f - mm); p.y = __builtin_amdgcn_exp2f(s[i][t].y * 1.4426950408889634f - mm);
                p.z = __builtin_amdgcn_exp2f(s[i][t].z * 1.4426950408889634f - mm); p.w = __builtin_amdgcn_exp2f(s[i][t].w * 1.4426950408889634f - mm); s[i][t] = p; lsum += (p.x + p.y) + (p.z + p.w); }
        lsum += __shfl_xor(lsum, 16); lsum += __shfl_xor(lsum, 32);
        f32x4 o[4];
#pragma unroll
        for (int dt = 0; dt < 4; ++dt) o[dt] = (f32x4){0.f, 0.f, 0.f, 0.f};
#pragma unroll
        for (int i = 0; i < 8; ++i) { const bf16x8 pa = pack8(s[i][0], s[i][1]);
            const int vrow = (brow0 + i) * 64 + cw0 + 4 * g + (i16 >> 2); const int sw = ((vrow >> 1) & 3) << 5;
#pragma unroll
            for (int dt = 0; dt < 4; ++dt) { const int colb = (dt * 16 + 4 * (i16 & 3)) * 2;
                const s16x4 lo = lds_tr16(Vs + vrow * 128 + (colb ^ sw)), hi = lds_tr16(Vs + (vrow + 16) * 128 + (colb ^ sw));
                o[dt] = __builtin_amdgcn_mfma_f32_16x16x32_bf16(pa, cat8(lo, hi), o[dt], 0, 0, 0); } }
        float linv[4];
#pragma unroll
        for (int reg = 0; reg < 4; ++reg) linv[reg] = 1.0f / __shfl(lsum, 4 * g + reg);
#pragma unroll
        for (int reg = 0; reg < 4; ++reg) { bf16* yr = Y + ((size_t)b * SEQ + rr * 64 + 16 * a + 4 * g + reg) * 512 + h * 64 + i16;
#pragma unroll
            for (int dt = 0; dt < 4; ++dt) yr[dt * 16] = (bf16)f2bf(o[dt][reg] * linv[reg]); }
    }
    __syncthreads();
}
__device__ __forceinline__ void p2_mem_mfma(Frame& F) {
    unsigned char* ws = F.ws; const int tid = F.tid, lane = F.lane, w = F.wave, g = lane >> 4, i16 = lane & 15;
    const bf16* QM = (const bf16*)(ws + WS_QM); const bf16* KVM = (const bf16*)(ws + WS_KVM); bf16* Y = (bf16*)(ws + WS_QM);
    LAS unsigned char* Ks = F.lds; LAS unsigned char* Vs = F.lds + 65536;
    constexpr float C2 = 0.08838834764831845f * 1.4426950408889634f;
    for (int unit = blockIdx.x; unit < 512; unit += F.G) {
        const int qb = unit & 31, h = (unit >> 5) & 3, b = unit >> 7;
        __syncthreads();
#pragma unroll
        for (int j = 0; j < 8; ++j) { const int row = j * 32 + (tid >> 4), ch = tid & 15; const bf16* src = KVM + ((size_t)(b * 256 + row)) * 1024 + h * 128 + ch * 8;
            const u32x4 kv = *(const u32x4*)src; const u32x4 vv = *(const u32x4*)(src + 512);
            *(LAS u32x4*)(Ks + row * 256 + ((ch ^ (row & 15)) << 4)) = kv; *(LAS u32x4*)(Vs + row * 256 + ((ch * 16) ^ ((row & 7) << 5))) = vv; }
        __syncthreads();
        const size_t qtok = (size_t)b * SEQ + qb * 128 + w * 16;
        bf16x8 qf[4];
#pragma unroll
        for (int ks = 0; ks < 4; ++ks) qf[ks] = *(const bf16x8*)(QM + (qtok + i16) * 512 + h * 128 + 32 * ks + 8 * g);
        f32x4 s[16];
#pragma unroll
        for (int t = 0; t < 16; ++t) { f32x4 acc = (f32x4){0.f, 0.f, 0.f, 0.f}; const LAS unsigned char* kb = Ks + (16 * t + i16) * 256;
#pragma unroll
            for (int ks = 0; ks < 4; ++ks) acc = __builtin_amdgcn_mfma_f32_16x16x32_bf16(*(const LAS bf16x8*)(kb + (((4 * ks + g) ^ i16) << 4)), qf[ks], acc, 0, 0, 0);
            s[t] = acc; }
        float m = -3e38f;
#pragma unroll
        for (int t = 0; t < 16; ++t) m = fmaxf(fmaxf(fmaxf(s[t].x, s[t].y), fmaxf(s[t].z, s[t].w)), m);
        m = fmaxf(m, __shfl_xor(m, 16)); m = fmaxf(m, __shfl_xor(m, 32));
        float lsum = 0.f; const float mm = m * C2;
#pragma unroll
        for (int t = 0; t < 16; ++t) { f32x4 p; p.x = __builtin_amdgcn_exp2f(s[t].x * C2 - mm); p.y = __builtin_amdgcn_exp2f(s[t].y * C2 - mm); p.z = __builtin_amdgcn_exp2f(s[t].z * C2 - mm); p.w = __builtin_amdgcn_exp2f(s[t].w * C2 - mm);
            s[t] = p; lsum += (p.x + p.y) + (p.z + p.w); }
        lsum += __shfl_xor(lsum, 16); lsum += __shfl_xor(lsum, 32);
        f32x4 o[8];
#pragma unroll
        for (int dt = 0; dt < 8; ++dt) o[dt] = (f32x4){0.f, 0.f, 0.f, 0.f};
        const int rk = (4 * g + (i16 >> 2)) & 7;
        bf16x8 pa[8];
#pragma unroll
        for (int st = 0; st < 8; ++st) pa[st] = pack8(s[2 * st], s[2 * st + 1]);
        const LAS unsigned char* vbase = Vs + (4 * g + (i16 >> 2)) * 256 + 8 * (i16 & 3);
#pragma unroll
        for (int dt = 0; dt < 8; ++dt) { const LAS unsigned char* vp = vbase + ((dt ^ rk) << 5);
#pragma unroll
            for (int st = 0; st < 8; ++st) { const s16x4 lo = lds_tr16(vp + st * 8192), hi = lds_tr16(vp + st * 8192 + 4096);
                o[dt] = __builtin_amdgcn_mfma_f32_16x16x32_bf16(pa[st], cat8(lo, hi), o[dt], 0, 0, 0); } }
        float linv[4];
#pragma unroll
        for (int reg = 0; reg < 4; ++reg) linv[reg] = 1.0f / __shfl(lsum, 4 * g + reg);
#pragma unroll
        for (int reg = 0; reg < 4; ++reg) { bf16* yr = Y + (qtok + 4 * g + reg) * 512 + h * 128 + i16;
#pragma unroll
            for (int dt = 0; dt < 8; ++dt) yr[dt * 16] = (bf16)f2bf(o[dt][reg] * linv[reg]); }
    }
    __syncthreads();
}
__device__ __forceinline__ void p3_carry(Frame& F) {
    if (F.wave != 0) return;
    unsigned char* ws = F.ws; const Args& A = *F.a; const int item = blockIdx.x; if (item >= 256) return;
    const int g = item >> 3, dir = (item >> 2) & 1, b = item & 3, p = F.lane;
    const int pi = (dir * 32 + g) * 64 + p; const f32x2 lamL = s5_cpow(A.in[I_ARE][pi], A.in[I_AIM][pi], expf(A.in[I_LOGDT][dir * 32 + g]), CL);
    const float* sl = (const float*)(ws + WS_SLOC) + ((size_t)(g * NCR + b * NCH)) * 256 + dir * 128 + p;
    bf16* u2 = (bf16*)(ws + WS_U2) + ((size_t)(g * NCR + b * NCH)) * U2K + 512 + dir * 128 + p;
    f32x2 S = (f32x2){0.f, 0.f};
    for (int c0 = 0; c0 < NCH; c0 += 16) {
        float re[16], im[16];
#pragma unroll
        for (int j = 0; j < 16; ++j) { const int c = dir == 0 ? (c0 + j) : (NCH - 1 - c0 - j); re[j] = sl[(size_t)c * 256]; im[j] = sl[(size_t)c * 256 + 64]; }
#pragma unroll
        for (int j = 0; j < 16; ++j) { const int c = dir == 0 ? (c0 + j) : (NCH - 1 - c0 - j);
            u2[(size_t)c * U2K] = (bf16)f2bf(S.x); u2[(size_t)c * U2K + 64] = (bf16)f2bf(S.y);
            const f32x2 ns = cmul(lamL, S); S = (f32x2){ns.x + re[j], ns.y + im[j]}; }
    }
}
__device__ __forceinline__ void p4_s5_direct(Frame& F) {
    if (F.wave != 0 || blockIdx.x >= 128) return;
    unsigned char* ws = F.ws; const Args& A = *F.a; const int lane = F.lane;
    const int b = blockIdx.x >> 5, g = blockIdx.x & 31, p = lane;
    float* yscr = F.a->out; const bf16* U2 = (const bf16*)(ws + WS_U2); bf16* Z = (bf16*)(ws + WS_Z);
    for (int dir = 0; dir < 2; ++dir) {
        const int pi = (dir * 32 + g) * 64 + p; const float lr = A.in[I_ARE][pi], li = A.in[I_AIM][pi], dtv = expf(A.in[I_LOGDT][dir * 32 + g]);
        const f32x2 lb = s5_cpow(lr, li, dtv, 1), q = s5_q(lr, li, dtv);
        f32x2 bb[16], cm[16];
#pragma unroll
        for (int ci = 0; ci < 16; ++ci) { bb[ci] = cmul(q, (f32x2){A.in[I_BRE][(size_t)pi * 16 + ci], A.in[I_BIM][(size_t)pi * 16 + ci]});
            const int cidx = ((dir * 32 + g) * 16 + ci) * 64 + p; cm[ci] = (f32x2){A.in[I_CRE][cidx], A.in[I_CIM][cidx]}; }
        f32x2 s = (f32x2){0.f, 0.f};
        const int myco = (lane >> 2) & 15; const float dsk = A.in[I_S5D][g * 16 + myco];
        for (int step = 0; step < SEQ; ++step) {
            const int t = dir == 0 ? step : SEQ - 1 - step;
            const bf16* up = U2 + ((size_t)(g * NCR + b * NCH + (t >> 5))) * U2K + (t & 31) * 16;
            const u32x4 w0 = ((const u32x4*)up)[0], w1 = ((const u32x4*)up)[1];
            float uu[16]; uu[0] = bflo(w0.x); uu[1] = bfhi(w0.x); uu[2] = bflo(w0.y); uu[3] = bfhi(w0.y); uu[4] = bflo(w0.z); uu[5] = bfhi(w0.z); uu[6] = bflo(w0.w); uu[7] = bfhi(w0.w);
            uu[8] = bflo(w1.x); uu[9] = bfhi(w1.x); uu[10] = bflo(w1.y); uu[11] = bfhi(w1.y); uu[12] = bflo(w1.z); uu[13] = bfhi(w1.z); uu[14] = bflo(w1.w); uu[15] = bfhi(w1.w);
            f32x2 bu = (f32x2){0.f, 0.f};
#pragma unroll
            for (int ci = 0; ci < 16; ++ci) { bu.x += bb[ci].x * uu[ci]; bu.y += bb[ci].y * uu[ci]; }
            const f32x2 ns = cmul(lb, s); s = (f32x2){ns.x + bu.x, ns.y + bu.y};
            float v16[16];
#pragma unroll
            for (int co = 0; co < 16; ++co) v16[co] = cm[co].x * s.x - cm[co].y * s.y;
            const bool h1 = (lane >> 5) & 1, h2 = (lane >> 4) & 1, h3 = (lane >> 3) & 1, h4 = (lane >> 2) & 1;
            float v8[8], v4[4], v2[2], v1;
#pragma unroll
            for (int i = 0; i < 8; ++i) { const float snd = h1 ? v16[i] : v16[8 + i], kp = h1 ? v16[8 + i] : v16[i]; v8[i] = kp + __shfl_xor(snd, 32); }
#pragma unroll
            for (int i = 0; i < 4; ++i) { const float snd = h2 ? v8[i] : v8[4 + i], kp = h2 ? v8[4 + i] : v8[i]; v4[i] = kp + __shfl_xor(snd, 16); }
#pragma unroll
            for (int i = 0; i < 2; ++i) { const float snd = h3 ? v4[i] : v4[2 + i], kp = h3 ? v4[2 + i] : v4[i]; v2[i] = kp + __shfl_xor(snd, 8); }
            { const float snd = h4 ? v2[0] : v2[1], kp = h4 ? v2[1] : v2[0]; v1 = kp + __shfl_xor(snd, 4); }
            v1 += __shfl_xor(v1, 2); v1 += __shfl_xor(v1, 1);
            if ((lane & 3) == 0) { const size_t o = ((size_t)(b * SEQ + t)) * 512 + g * 16 + myco;
                if (dir == 0) yscr[o] = v1;
                else { const float y = yscr[o] + v1 + dsk * bf2f(up[myco]); Z[o] = (bf16)f2bf(gelu_tanh(y)); } }
        }
    }
}
__device__ __forceinline__ void p10_final(Frame& F) {
    const float* ss = (const float*)(F.ws + WS_SS2); const f32x4* gr = (const f32x4*)F.a->in[I_GFINAL] + F.lane;
    for (int m = F.gw; m < T; m += F.NGW) {
        const float rstd = 1.0f / sqrtf(ss[m] * (1.f / 1024.f) + EPS); f32x4* xr = (f32x4*)(F.a->out + (size_t)m * D) + F.lane;
#pragma unroll
        for (int j = 0; j < 4; ++j) { const f32x4 v = xr[64 * j], gg = gr[64 * j]; xr[64 * j] = (f32x4){v.x * rstd * gg.x, v.y * rstd * gg.y, v.z * rstd * gg.z, v.w * rstd * gg.w}; }
    }
}

#ifndef MK_PER_PHASE
#define MK_PER_PHASE 0
#endif
#ifndef MK_FLAGS
#define MK_FLAGS 0
#endif
#define MK_WITH_NAIVE ((MK_FLAGS) & 1)
constexpr int N_PHASES = 11;
template <bool NAIVE_GEMM>
__device__ __forceinline__ void fwd_body(const Args& args, unsigned char* lds_raw) {
    Frame F; F.lds = (LAS unsigned char*)lds_raw; F.a = &args; F.ws = args.ws;
    F.tid = threadIdx.x; F.lane = F.tid & 63; F.wave = __builtin_amdgcn_readfirstlane(F.tid >> 6); F.G = gridDim.x;
    F.gw = blockIdx.x * NWAVES + F.wave; F.NGW = F.G * NWAVES;
    volatile LAS unsigned* MISC = (volatile LAS unsigned*)(F.lds + MISC_OFF);
    for (int u = F.tid; u < (LDS_BYTES - LDSCTL_OFF) / 4; u += NWAVES * 64) ((LAS unsigned*)(F.lds + LDSCTL_OFF))[u] = 0u;
    __syncthreads();
    unsigned char* ws = args.ws;
    const bool multi = (args.ph_hi - args.ph_lo) > 1;
    XcdBarrier bar; bar.bar = (unsigned*)(ws + WS_CTL) + CW_BAR; bar.x = 0; bar.st = nullptr;
    if (multi) bar = xcd_barrier_post((unsigned*)(ws + WS_CTL) + CW_BAR, MISC + 8);
    const int lo = args.ph_lo, hi = args.ph_hi; const int c = blockIdx.x;
#define IN(k) (lo <= (k) && (k) < hi)
#define SEAM(k) do { if (IN(k) && IN((k) + 1)) xcd_barrier(bar); } while (0)
    if (IN(0)) { p0_prologue(F); } SEAM(0);
    if (IN(1)) { p1_toeplitz(F);
        SchedP1 S{F.G, c, (const char*)(ws + WS_H), (const char*)(ws + WS_WIN), (const char*)(ws + WS_MEMN), (const char*)(ws + WS_WMKV)}; EpiP1 E{ws};
        run_gemm EpiP1, SchedP1, true>(F, S, E); } SEAM(1);
    if (IN(2)) { SchedC1 S{c, (const char*)(ws + WS_U2), (const char*)(ws + WS_WEND)}; EpiC1 E{ws};
        run_gemm EpiC1, SchedC1, false>(F, S, E);
        if (args.flags & FL_SIMPLE_NA) p2_na_simple(F); else p2_na_mfma(F);
        if (args.flags & FL_SIMPLE_MEM) p2_mem_simple(F); else p2_mem_mfma(F); } SEAM(2);
    if (IN(3)) { p3_carry(F); } SEAM(3);
    if (IN(4)) { if (args.flags & FL_NAIVE_S5) p4_s5_direct(F);
        else { SchedC3 S{c, (const char*)(ws + WS_U2), (const char*)(ws + WS_WTOEP)}; EpiC3 E{ws}; run_gemm EpiC3, SchedC3, false>(F, S, E); } } SEAM(4);
    if (IN(5)) { SchedP5 S{c, (const char*)(ws + WS_Z), (const char*)(ws + WS_WGLU)}; EpiP5 E{ws}; run_gemm EpiP5, SchedP5, false>(F, S, E); } SEAM(5);
    if (IN(6)) { SchedP6 S; pg8::tile_order(c, 64, 4, S.pm, S.pn); S.ws = (const char*)ws;
        EpiP6 E{ws, args.out + (size_t)blockIdx.x * (32 * 512 * 4), args.in[I_BGATE]};
        if (c < 256) run_gemm EpiP6, SchedP6, true>(F, S, E); } SEAM(6);
    if (IN(7)) { SchedP7 S{c, (const char*)(ws + WS_MERGED), (const char*)(ws + WS_WO), 2048, 2048, 16}; EpiRes<true> E{args.in[I_X], args.out, (bf16*)(ws + WS_X1B), (float*)(ws + WS_SS1)};
        if (c < 256) run_gemm EpiRes<true>, SchedP7, false>(F, S, E); } SEAM(7);
    if (IN(8)) { SchedP8 S{F.G, c, (const char*)(ws + WS_X1B), (const char*)(ws + WS_W13)}; EpiP8 E{ws}; run_gemm EpiP8, SchedP8, true>(F, S, E); } SEAM(8);
    if (IN(9)) { SchedP7 S{c, (const char*)(ws + WS_TT), (const char*)(ws + WS_W2), DFF * 2, DFF * 2, DFF / 64}; EpiRes<false> E{args.out, args.out, nullptr, (float*)(ws + WS_SS2)};
        if (c < 256) run_gemm EpiRes<false>, SchedP7, false>(F, S, E); } SEAM(9);
    if (IN(10)) { p10_final(F); }
#undef IN
#undef SEAM
}
#undef run_gemm
__global__ void __launch_bounds__(NWAVES * 64, 2) fwd_kernel(Args args) {
    extern __shared__ __attribute__((aligned(16))) unsigned char lds_raw[];
    fwd_body<false>(args, lds_raw);
}
#if MK_WITH_NAIVE
__global__ void __launch_bounds__(NWAVES * 64, 2) fwd_kernel_naive(Args args) {
    extern __shared__ __attribute__((aligned(16))) unsigned char lds_raw[];
    fwd_body<true>(args, lds_raw);
}
#endif

#if MK_WITH_NAIVE
#define KERNEL_FN fwd_kernel_naive
#else
#define KERNEL_FN fwd_kernel
#endif
extern "C" void kernel_launch(void* const* d_in, const int* in_sizes, int n_in, void* d_out, int out_size, void* d_ws, size_t ws_size, hipStream_t stream) {
    static int grid = 0;
    if (grid == 0) {
        if (n_in != 25 || out_size != T * D || ws_size < WS_END) { fprintf(stderr, "kernel_launch: unexpected shapes (n_in %d out %d ws %zu)\n", n_in, out_size, ws_size); grid = -1; return; }
        if (hipFuncSetAttribute((const void*)KERNEL_FN, hipFuncAttributeMaxDynamicSharedMemorySize, LDS_BYTES) != hipSuccess) { fprintf(stderr, "kernel_launch: hipFuncSetAttribute failed\n"); grid = -1; return; }
        int dev = 0, cus = 0; if (hipGetDevice(&dev) != hipSuccess || hipDeviceGetAttribute(&cus, hipDeviceAttributeMultiprocessorCount, dev) != hipSuccess) { grid = -1; return; }
        (void)hipGetLastError();
        grid = cus;
        if (grid != 256) fprintf(stderr, "kernel_launch: %d CUs (built for 256)\n", grid);
    }
    if (grid < 0) return;
    (void)hipMemsetAsync((char*)d_ws + WS_CTL, 0, CTL_ZERO_BYTES, stream);
    Args a{};
    for (int i = 0; i < 25; ++i) a.in[i] = (const float*)d_in[i];
    a.out = (float*)d_out; a.ws = (unsigned char*)d_ws; a.flags = MK_FLAGS; a.li = 0;
#if MK_PER_PHASE
    for (int ph = 0; ph < N_PHASES; ++ph) { a.ph_lo = ph; a.ph_hi = ph + 1; hipLaunchKernelGGL(KERNEL_FN, dim3(grid), dim3(NWAVES * 64), LDS_BYTES, stream, a); }
#else
    a.ph_lo = 0; a.ph_hi = N_PHASES; hipLaunchKernelGGL(KERNEL_FN, dim3(grid), dim3(NWAVES * 64), LDS_BYTES, stream, a);
#endif
}
```
